# Optimizing an MI355X kernel written in HIP

```python
import math
import jax, jax.numpy as jnp
from jax import lax
import numpy as np

D_MODEL = 4096
BATCH = 8
SEQ = 2048
DEPTH = 2
DEC_BATCH = 16
DEC_SEQ = 16
PAST_LEN = 4096

CHUNK = 64
WINDOW = 128
N_SWA_LAYERS = (DEPTH + 1) // 2
N_GDN_LAYERS = DEPTH // 2
ATTN_WIDTH = D_MODEL // 2
HEAD_DIM_A = 64
N_Q_HEADS = ATTN_WIDTH // HEAD_DIM_A
N_KV_HEADS = N_Q_HEADS // 8
GROUP = N_Q_HEADS // N_KV_HEADS
ROT_DIM = HEAD_DIM_A // 4
ROPE_THETA = 500000.0
SCONV_CH = D_MODEL - ATTN_WIDTH
SCONV_WIDTH = 3
KV_WIDTH = N_KV_HEADS * HEAD_DIM_A
MIX0_WIDTH = ATTN_WIDTH + SCONV_CH
IN0_WIDTH = ATTN_WIDTH + 2 * KV_WIDTH + 3 * SCONV_CH
GDN_HEAD_DIM = 128
N_GDN_HEADS = D_MODEL // GDN_HEAD_DIM
GDN_WIDTH = N_GDN_HEADS * GDN_HEAD_DIM
GDN_CONV_WIDTH = 4
QKV_CH = 3 * GDN_WIDTH
IN1_WIDTH = QKV_CH + GDN_WIDTH + 2 * N_GDN_HEADS
D_FF = 4 * D_MODEL
EPS = 1e-6
NEG_INF = -1e30

kernel_name = "hybrid_swa_sconv_gdn_stream_step"


def rmsnorm(x, g):
    xf = x.astype(jnp.float32)
    y = xf * lax.rsqrt(jnp.mean(xf * xf, axis=-1, keepdims=True) + EPS)
    return (y * g.astype(jnp.float32)).astype(x.dtype)


def rope_partial(x, pos):
    half = ROT_DIM // 2
    inv = ROPE_THETA ** (-jnp.arange(half, dtype=jnp.float32) / half)
    ang = pos.astype(jnp.float32)[:, None] * inv[None, :]
    cos = jnp.cos(ang)[None, :, None, :]
    sin = jnp.sin(ang)[None, :, None, :]
    xr = x[..., :ROT_DIM].astype(jnp.float32)
    x1, x2 = xr[..., :half], xr[..., half:]
    rot = jnp.concatenate([x1 * cos - x2 * sin, x2 * cos + x1 * sin], axis=-1)
    return jnp.concatenate([rot.astype(x.dtype), x[..., ROT_DIM:]], axis=-1)


def causal_dwconv(u, buf, w):
    width = w.shape[0]
    T = u.shape[1]
    uf = jnp.concatenate([buf.astype(u.dtype), u], axis=1)
    out = sum(uf[:, i:i + T] * w[i] for i in range(width))
    return out, uf[:, -(width - 1):]


def sink_attention(q, k, v, sinks, valid):
    s = jnp.einsum('nqhgd,nkhd->nhgqk', q.astype(jnp.float32), k.astype(jnp.float32)) * (HEAD_DIM_A ** -0.5)
    if valid is not None:
        s = jnp.where(valid[:, None, None, None, :], s, NEG_INF)
    sink = jnp.broadcast_to(sinks.astype(jnp.float32).reshape(1, N_KV_HEADS, GROUP, 1, 1), s.shape[:-1] + (1,))
    p = jax.nn.softmax(jnp.concatenate([s, sink], axis=-1), axis=-1)[..., :-1]
    o = jnp.einsum('nhgqk,nkhd->nqhgd', p, v.astype(jnp.float32))
    return o.astype(v.dtype)


def banded_swa(q, k, v, sinks):
    N, S = q.shape[:2]
    nc = S // CHUNK
    nb = WINDOW // CHUNK
    band = (nb + 1) * CHUNK
    qb = q.reshape(N * nc, CHUNK, N_KV_HEADS, GROUP, HEAD_DIM_A)
    pad = ((0, 0), (WINDOW, 0), (0, 0), (0, 0))
    kc = jnp.pad(k, pad).reshape(N, nc + nb, CHUNK, N_KV_HEADS, HEAD_DIM_A)
    vc = jnp.pad(v, pad).reshape(N, nc + nb, CHUNK, N_KV_HEADS, HEAD_DIM_A)
    kband = jnp.concatenate([kc[:, i:i + nc] for i in range(nb + 1)], axis=2).reshape(N * nc, band, N_KV_HEADS, HEAD_DIM_A)
    vband = jnp.concatenate([vc[:, i:i + nc] for i in range(nb + 1)], axis=2).reshape(N * nc, band, N_KV_HEADS, HEAD_DIM_A)
    key_pos = jnp.arange(nc)[:, None] * CHUNK - WINDOW + jnp.arange(band)[None, :]
    valid = jnp.broadcast_to((key_pos >= 0)[None], (N, nc, band)).reshape(N * nc, band)
    o = sink_attention(qb, kband, vband, sinks, valid)
    return o.reshape(N, S, ATTN_WIDTH)


def swa_sconv_mixer(x, pos, k_cache, v_cache, conv_buf, norm_g, w_in, sinks, conv_w, w_out):
    N, T, _ = x.shape
    h = rmsnorm(x, norm_g)
    proj = h @ w_in
    splits = np.cumsum([ATTN_WIDTH, KV_WIDTH, KV_WIDTH, SCONV_CH, SCONV_CH]).tolist()
    q, k, v, b_gate, c_gate, xc = jnp.split(proj, splits, axis=-1)
    q = rope_partial(q.reshape(N, T, N_Q_HEADS, HEAD_DIM_A), pos)
    k = rope_partial(k.reshape(N, T, N_KV_HEADS, HEAD_DIM_A), pos)
    v = v.reshape(N, T, N_KV_HEADS, HEAD_DIM_A)
    if k_cache is None:
        attn = banded_swa(q, k, v, sinks)
        k_all, v_all = k, v
        conv_buf = jnp.zeros((N, SCONV_WIDTH - 1, SCONV_CH), x.dtype)
    else:
        k_all = jnp.concatenate([k_cache.astype(k.dtype), k], axis=1)
        v_all = jnp.concatenate([v_cache.astype(v.dtype), v], axis=1)
        o = sink_attention(q.reshape(N, T, N_KV_HEADS, GROUP, HEAD_DIM_A), k_all, v_all, sinks, None)
        attn = o.reshape(N, T, ATTN_WIDTH)
    conv, new_buf = causal_dwconv(c_gate * xc, conv_buf, conv_w)
    y = jnp.concatenate([attn.astype(x.dtype), b_gate * conv], axis=-1) @ w_out
    return x + y, k_all[:, -WINDOW:], v_all[:, -WINDOW:], new_buf


def gated_delta_rule(q, k, v, g, beta, S0, chunk):
    N, T, H, _ = q.shape
    nc = T // chunk

    def blk(a):
        return a.reshape(N, nc, chunk, H, *a.shape[3:]).swapaxes(2, 3)

    q, k, v, g, beta = blk(q), blk(k), blk(v), blk(g), blk(beta)
    G = jnp.cumsum(g, axis=-1)
    idx = jnp.arange(chunk)
    lower_incl = idx[:, None] >= idx[None, :]
    strict = idx[:, None] > idx[None, :]
    decay_mat = jnp.exp(jnp.where(lower_incl, G[..., :, None] - G[..., None, :], -jnp.inf))
    kb = k * beta[..., None]
    A = jnp.where(strict, jnp.einsum('...id,...jd->...ij', kb, k) * decay_mat, 0.0)
    eye = jnp.eye(chunk, dtype=jnp.float32)
    rhs = jnp.concatenate([v * beta[..., None], kb * jnp.exp(G)[..., None]], axis=-1)
    sol = lax.linalg.triangular_solve(eye + A, rhs, left_side=True, lower=True)
    dv = v.shape[-1]
    u_base, w = sol[..., :dv], sol[..., dv:]
    aqk = jnp.einsum('...id,...jd->...ij', q, k) * decay_mat
    q_dec = q * jnp.exp(G)[..., None]
    k_dec = k * jnp.exp(G[..., -1:] - G)[..., None]
    blk_decay = jnp.exp(G[..., -1])

    def step(S, xs):
        u_b, w_c, a_c, qd, kd, cd = xs
        u = u_b - jnp.einsum('nhld,nhdv->nhlv', w_c, S)
        o = jnp.einsum('nhld,nhdv->nhlv', qd, S) + jnp.einsum('nhij,nhjv->nhiv', a_c, u)
        S = S * cd[..., None, None] + jnp.einsum('nhld,nhlv->nhdv', kd, u)
        return S, o

    xs = tuple(jnp.moveaxis(a, 1, 0) for a in (u_base, w, aqk, q_dec, k_dec, blk_decay))
    S, o = lax.scan(step, S0, xs)
    o = o.transpose(1, 0, 3, 2, 4).reshape(N, T, H, dv)
    return o, S


def gdn_mixer(x, conv_buf, S0, norm_g, w_in, conv_w, A_log, dt_bias, o_norm_w, w_out, chunk):
    N, T, _ = x.shape
    h = rmsnorm(x, norm_g)
    proj = h @ w_in
    splits = np.cumsum([QKV_CH, GDN_WIDTH, N_GDN_HEADS]).tolist()
    qkv, gate, a, b = jnp.split(proj, splits, axis=-1)
    if conv_buf is None:
        conv_buf = jnp.zeros((N, GDN_CONV_WIDTH - 1, QKV_CH), x.dtype)
    if S0 is None:
        S0 = jnp.zeros((N, N_GDN_HEADS, GDN_HEAD_DIM, GDN_HEAD_DIM), jnp.float32)
    qkv_c, new_buf = causal_dwconv(qkv, conv_buf, conv_w)
    qkv_c = jax.nn.silu(qkv_c.astype(jnp.float32))
    q, k, v = jnp.split(qkv_c, [GDN_WIDTH, 2 * GDN_WIDTH], axis=-1)
    shp = (N, T, N_GDN_HEADS, GDN_HEAD_DIM)
    q, k, v = q.reshape(shp), k.reshape(shp), v.reshape(shp)
    q = q * lax.rsqrt(jnp.sum(q * q, axis=-1, keepdims=True) + EPS) * (GDN_HEAD_DIM ** -0.5)
    k = k * lax.rsqrt(jnp.sum(k * k, axis=-1, keepdims=True) + EPS)
    beta = jax.nn.sigmoid(b.astype(jnp.float32))
    g = -jnp.exp(A_log.astype(jnp.float32)) * jax.nn.softplus(a.astype(jnp.float32) + dt_bias.astype(jnp.float32))
    o, S = gated_delta_rule(q, k, v, g, beta, S0.astype(jnp.float32), chunk)
    o = o * lax.rsqrt(jnp.mean(o * o, axis=-1, keepdims=True) + EPS) * o_norm_w.astype(jnp.float32)
    o = o * jax.nn.silu(gate.astype(jnp.float32).reshape(shp))
    y = o.reshape(N, T, GDN_WIDTH).astype(x.dtype) @ w_out
    return x + y, new_buf, S.astype(x.dtype)


def sqrelu_mlp(x, norm_g, w_up, w_down):
    h = rmsnorm(x, norm_g)
    return x + jnp.square(jax.nn.relu(h @ w_up)) @ w_down


def setup_inputs(seed: int = 0) -> dict:
    key = jax.random.key(seed)
    ks = iter(jax.random.split(key, 32))
    f32 = jnp.float32

    def nrm(shape, scale):
        return scale * jax.random.normal(next(ks), shape, f32)

    def gain(shape):
        return 1.0 + nrm(shape, 0.02)

    NS, NG = N_SWA_LAYERS, N_GDN_LAYERS
    n_win = min(WINDOW, PAST_LEN)
    x_prompt = nrm((BATCH, SEQ, D_MODEL), 1.0)
    x_sample = nrm((DEC_BATCH, DEC_SEQ, D_MODEL), 1.0)
    cache_swa_k = nrm((NS, DEC_BATCH, n_win, N_KV_HEADS, HEAD_DIM_A), 1.0)
    cache_swa_v = nrm((NS, DEC_BATCH, n_win, N_KV_HEADS, HEAD_DIM_A), 1.0)
    state_sconv = nrm((NS, DEC_BATCH, SCONV_WIDTH - 1, SCONV_CH), 1.0)
    state_dn_conv = nrm((NG, DEC_BATCH, GDN_CONV_WIDTH - 1, QKV_CH), 1.0)
    state_dn = nrm((NG, DEC_BATCH, N_GDN_HEADS, GDN_HEAD_DIM, GDN_HEAD_DIM), 0.5)
    attn_norm = gain((NS, D_MODEL))
    w_in_a = nrm((NS, D_MODEL, IN0_WIDTH), D_MODEL ** -0.5)
    sinks = nrm((NS, N_Q_HEADS), 0.5)
    sconv_w = nrm((NS, SCONV_WIDTH, SCONV_CH), SCONV_WIDTH ** -0.5)
    w_out_a = nrm((NS, MIX0_WIDTH, D_MODEL), MIX0_WIDTH ** -0.5)
    dn_norm = gain((NG, D_MODEL))
    w_in_g = nrm((NG, D_MODEL, IN1_WIDTH), D_MODEL ** -0.5)
    dn_conv_w = nrm((NG, GDN_CONV_WIDTH, QKV_CH), GDN_CONV_WIDTH ** -0.5)
    A_log = jnp.log(jax.random.uniform(next(ks), (NG, N_GDN_HEADS), f32, 1.0, 16.0))
    dt = jnp.exp(jax.random.uniform(next(ks), (NG, N_GDN_HEADS), f32, math.log(1e-3), math.log(1e-1)))
    dt_bias = dt + jnp.log(-jnp.expm1(-dt))
    o_norm_w = gain((NG, GDN_HEAD_DIM))
    w_out_g = nrm((NG, GDN_WIDTH, D_MODEL), GDN_WIDTH ** -0.5)
    mlp_norm = gain((DEPTH, D_MODEL))
    w_up = nrm((DEPTH, D_MODEL, D_FF), D_MODEL ** -0.5)
    w_down = nrm((DEPTH, D_FF, D_MODEL), D_FF ** -0.5)
    final_norm = gain((D_MODEL,))
    return {
        "x_prompt": x_prompt, "x_sample": x_sample,
        "cache_swa_k": cache_swa_k, "cache_swa_v": cache_swa_v, "state_sconv": state_sconv,
        "state_dn_conv": state_dn_conv, "state_dn": state_dn,
        "attn_norm": attn_norm, "w_in_a": w_in_a, "sinks": sinks, "sconv_w": sconv_w, "w_out_a": w_out_a,
        "dn_norm": dn_norm, "w_in_g": w_in_g, "dn_conv_w": dn_conv_w, "A_log": A_log, "dt_bias": dt_bias,
        "o_norm_w": o_norm_w, "w_out_g": w_out_g,
        "mlp_norm": mlp_norm, "w_up": w_up, "w_down": w_down, "final_norm": final_norm,
    }


def reference(x_prompt, x_sample, cache_swa_k, cache_swa_v, state_sconv, state_dn_conv, state_dn,
              attn_norm, w_in_a, sinks, sconv_w, w_out_a,
              dn_norm, w_in_g, dn_conv_w, A_log, dt_bias, o_norm_w, w_out_g,
              mlp_norm, w_up, w_down, final_norm):
    xp, xs = x_prompt, x_sample
    pos_p = jnp.arange(xp.shape[1])
    pos_s = PAST_LEN + jnp.arange(xs.shape[1])
    kp_l, vp_l, ks_l, vs_l, cp_l, cs_l = [], [], [], [], [], []
    dcp_l, dcs_l, dsp_l, dss_l = [], [], [], []
    for li in range(DEPTH):
        j = li // 2
        if li % 2 == 0:
            xp, kp, vp, cp = swa_sconv_mixer(xp, pos_p, None, None, None,
                                             attn_norm[j], w_in_a[j], sinks[j], sconv_w[j], w_out_a[j])
            xs, ks_, vs_, cs = swa_sconv_mixer(xs, pos_s, cache_swa_k[j], cache_swa_v[j], state_sconv[j],
                                               attn_norm[j], w_in_a[j], sinks[j], sconv_w[j], w_out_a[j])
            kp_l.append(kp); vp_l.append(vp); ks_l.append(ks_); vs_l.append(vs_)
            cp_l.append(cp); cs_l.append(cs)
        else:
            xp, dcp, dsp = gdn_mixer(xp, None, None, dn_norm[j], w_in_g[j], dn_conv_w[j], A_log[j],
                                     dt_bias[j], o_norm_w[j], w_out_g[j], CHUNK)
            xs, dcs, dss = gdn_mixer(xs, state_dn_conv[j], state_dn[j], dn_norm[j], w_in_g[j], dn_conv_w[j],
                                     A_log[j], dt_bias[j], o_norm_w[j], w_out_g[j], xs.shape[1])
            dcp_l.append(dcp); dcs_l.append(dcs); dsp_l.append(dsp); dss_l.append(dss)
        xp = sqrelu_mlp(xp, mlp_norm[li], w_up[li], w_down[li])
        xs = sqrelu_mlp(xs, mlp_norm[li], w_up[li], w_down[li])
    y_prompt = rmsnorm(xp, final_norm)
    y_sample = rmsnorm(xs, final_norm)
    swa_k_prompt = jnp.stack(kp_l, 0)
    swa_v_prompt = jnp.stack(vp_l, 0)
    swa_k_sample = jnp.stack(ks_l, 0)
    swa_v_sample = jnp.stack(vs_l, 0)
    sconv_prompt = jnp.stack(cp_l, 0)
    sconv_sample = jnp.stack(cs_l, 0)
    dn_conv_prompt = jnp.stack(dcp_l, 0)
    dn_conv_sample = jnp.stack(dcs_l, 0)
    dn_state_prompt = jnp.stack(dsp_l, 0)
    dn_state_sample = jnp.stack(dss_l, 0)
    return (y_prompt, y_sample, swa_k_prompt, swa_v_prompt, swa_k_sample, swa_v_sample,
            sconv_prompt, sconv_sample, dn_conv_prompt, dn_conv_sample, dn_state_prompt, dn_state_sample)
```

```cpp
#include <hip/hip_runtime.h>
#include <cstdio>
#include <cstdint>
namespace pg8 {
#define PG8_LAS __attribute__((address_space(3)))
typedef unsigned short bf16_t;
typedef short bf16x8 __attribute__((ext_vector_type(8)));
typedef float f32x4 __attribute__((ext_vector_type(4)));
typedef unsigned u32x4 __attribute__((ext_vector_type(4)));
constexpr int BM = 256, BK = 64, HALF = 128, HTB = HALF * BK * 2  , STAGE_BYTES = 8 * HTB, NXCD = 8, WGM = 8;

__host__ __device__ __forceinline__ int lds_byte(int r, int c) { const int st = (r >> 4) * 2 + (c >> 5), rr = r & 15, cc = c & 31, ob = rr * 64 + cc * 2; return st * 1024 + (ob ^ (((ob >> 9) & 1) << 5)); }
__host__ __device__ __forceinline__ void stage_rc(int b, int& R, int& C) { const int st = b / 1024, sb = b % 1024, swz = sb ^ (((sb >> 9) & 1) << 5); R = (st >> 1) * 16 + swz / 64; C = (st & 1) * 32 + (swz % 64) / 2; }
__host__ __device__ __forceinline__ int perm32(int rho) { const int n = rho >> 4, i = rho & 15; return 8 * (i >> 2) + 4 * n + (i & 3); }

struct Unit { int pm, pn; };
struct Gemm { const bf16_t* A; const bf16_t* Bt; int M, N, K; };

struct StaticOrder {
    int nM, nN, nwg, G, c;
    __host__ __device__ void init(int M, int N, int G_, int c_) { nM = M / BM; nN = N / BM; nwg = nM * nN; G = G_; c = c_; }
    __host__ __device__ bool next(int i, Unit& u) const {
        const long L = (long)i * G + c; if (L >= nwg) return false;
        int wgid = (int)L; { const int q = nwg / NXCD, r = nwg % NXCD, xcd = wgid % NXCD, off = wgid / NXCD; wgid = (xcd < r ? xcd * (q + 1) : r * (q + 1) + (xcd - r) * q) + off; }
        const int nig = WGM * nN, gid = wgid / nig, fm = gid * WGM, gsz = (nM - fm) < WGM ? (nM - fm) : WGM;
        u.pm = fm + ((wgid % nig) % gsz); u.pn = (wgid % nig) / gsz; return true;
    }
    __device__ __forceinline__ void a_ready(const Unit&) const {}
    __device__ __forceinline__ void done(const Unit&) const {}
};


__device__ __forceinline__ unsigned cvt_pk_bf16(float lo, float hi) { unsigned r; asm volatile("v_cvt_pk_bf16_f32 %0, %1, %2" : "=v"(r) : "v"(lo), "v"(hi)); return r; }
constexpr float RMS_EPS = 1e-6f;
constexpr int DMODEL = 4096;
template <int ACT> struct EpiRow {
    static constexpr bool PERM = true, AFTER_DRAIN = false;
    bf16_t* O; int ldc; const float* ssq; float* aux; int pn_aux;
    __device__ __forceinline__ void operator()(const f32x4 (&acc)[2][2][4][2], const Unit& u, int wr, int wc, int fr, int fq) const {
        const int row0 = u.pm * BM + wr * 64 + fr, ct = wc * 32 + 8 * fq;
        const bool isaux = (u.pn == pn_aux);
#pragma unroll
        for (int ai = 0; ai < 2; ++ai)
#pragma unroll
            for (int m = 0; m < 4; ++m) {
                const int row = row0 + ai * HALF + m * 16;
                const float rs = rsqrtf(ssq[row] * (1.0f / DMODEL) + RMS_EPS);
#pragma unroll
                for (int bj = 0; bj < 2; ++bj) {
                    f32x4 v0 = acc[ai][bj][m][0] * rs, v1 = acc[ai][bj][m][1] * rs;
                    if (ACT == 1) {
#pragma unroll
                        for (int j = 0; j < 4; ++j) { const float a = fmaxf(v0[j], 0.f), b = fmaxf(v1[j], 0.f); v0[j] = a * a; v1[j] = b * b; }
                    }
                    if (isaux) {
                        if (bj == 0 && ct < 64) { float* p = aux + (size_t)row * 64 + ct; *(f32x4*)p = v0; *(f32x4*)(p + 4) = v1; }
                    } else {
                        u32x4 w; w.x = cvt_pk_bf16(v0[0], v0[1]); w.y = cvt_pk_bf16(v0[2], v0[3]); w.z = cvt_pk_bf16(v1[0], v1[1]); w.w = cvt_pk_bf16(v1[2], v1[3]);
                        *(u32x4*)(O + (size_t)row * ldc + u.pn * BM + ct + bj * HALF) = w;
                    }
                }
            }
    }
};
struct EpiRes {
    static constexpr bool PERM = false, AFTER_DRAIN = false;
    const float* base_p; const float* base_s; float* out; bf16_t* xb; float* ssq;
    __device__ __forceinline__ void operator()(const f32x4 (&acc)[2][2][4][2], const Unit& u, int wr, int wc, int fr, int fq) const {
        const int row0 = u.pm * BM + wr * 64 + fr, col0 = u.pn * BM + wc * 32 + 4 * fq;
        const float* bp = (u.pm < 64) ? base_p : (base_s - (size_t)16384 * DMODEL);
#pragma unroll
        for (int ai = 0; ai < 2; ++ai)
#pragma unroll
            for (int m = 0; m < 4; ++m) {
                const int row = row0 + ai * HALF + m * 16; const size_t off = (size_t)row * DMODEL + col0;
                float s = 0.f;
#pragma unroll
                for (int bj = 0; bj < 2; ++bj)
#pragma unroll
                    for (int n = 0; n < 2; ++n) {
                        const f32x4 b = *(const f32x4*)(bp + off + bj * HALF + n * 16);
                        const f32x4 o = b + acc[ai][bj][m][n];
                        *(f32x4*)(out + off + bj * HALF + n * 16) = o;
                        s += (o[0] * o[0] + o[1] * o[1]) + (o[2] * o[2] + o[3] * o[3]);
                        if (xb) { typedef unsigned u32x2 __attribute__((ext_vector_type(2))); u32x2 w; w.x = cvt_pk_bf16(o[0], o[1]); w.y = cvt_pk_bf16(o[2], o[3]); *(u32x2*)(xb + off + bj * HALF + n * 16) = w; }
                    }
                s += __shfl_xor(s, 16); s += __shfl_xor(s, 32);
                if (fq == 0) unsafeAtomicAdd(ssq + row, s);
            }
    }
};
template <class Epi, class Sched, bool ALIGN_EPI = false, bool SP2 = false>
__device__ __forceinline__ void gemm_phase(PG8_LAS unsigned char* lds, const Gemm g, const Sched& S, const Epi& E) {
    const int tid = threadIdx.x, wid = __builtin_amdgcn_readfirstlane(tid >> 6), lane = tid & 63, wr = wid >> 2, wc = wid & 3, fr = lane & 15, fq = lane >> 4;
    const int K = g.K, nt = K / BK;
    unsigned voffA[2], voffB[2];
#pragma unroll
    for (int i = 0; i < 2; ++i) { int R, C; stage_rc(tid * 16 + i * 8192, R, C); const int Rb = Epi::PERM ? ((R & ~31) + perm32(R & 31)) : R;
        voffA[i] = (unsigned)(R * K + C) * 2u; voffB[i] = (unsigned)(Rb * K + C) * 2u; }
    const size_t kstep = (size_t)(BK * 2);
    const size_t hstep = (size_t)HALF * K * 2;
    const size_t tstep = 2 * hstep;
    const unsigned ldsw = (unsigned)wid * 1024u;
    const int aoff = lds_byte(wr * 64 + fr, fq * 8), boff = lds_byte(wc * 32 + fr, fq * 8);
#define PG8_SA(b, h) (((b) * 2 + (h)) * HTB)
#define PG8_SB(b, h) ((4 + (b) * 2 + (h)) * HTB)
#define PG8_STAGE(bufoff, gbase, voff) do { _Pragma("unroll") for (int _i = 0; _i < 2; ++_i) \
        __builtin_amdgcn_global_load_lds((const unsigned*)((const char*)(gbase) + (voff)[_i]), (PG8_LAS unsigned*)(lds + (bufoff) + ldsw + _i * 8192), 16, 0, 0); } while (0)
#define PG8_LDA(dst, b, h) do { _Pragma("unroll") for (int m = 0; m < 4; ++m) _Pragma("unroll") for (int k = 0; k < 2; ++k) dst[m][k] = *(const PG8_LAS bf16x8*)(lds + PG8_SA(b, h) + aoff + m * 2048 + k * 1024); } while (0)
#define PG8_LDB(dst, b, h) do { _Pragma("unroll") for (int n = 0; n < 2; ++n) _Pragma("unroll") for (int k = 0; k < 2; ++k) dst[n][k] = *(const PG8_LAS bf16x8*)(lds + PG8_SB(b, h) + boff + n * 2048 + k * 1024); } while (0)
#define PG8_MMA(ai, bj, At, Bt) do { __builtin_amdgcn_s_setprio(1); _Pragma("unroll") for (int m = 0; m < 4; ++m) _Pragma("unroll") for (int n = 0; n < 2; ++n) _Pragma("unroll") for (int k = 0; k < 2; ++k) \
        acc[ai][bj][m][n] = __builtin_amdgcn_mfma_f32_16x16x32_bf16(Bt[n][k], At[m][k], acc[ai][bj][m][n], 0, 0, 0); __builtin_amdgcn_s_setprio(0); } while (0)
#define PG8_WAIT_V(n) asm volatile("s_waitcnt vmcnt(" #n ")" ::: "memory")
#define PG8_WAIT_L(n) asm volatile("s_waitcnt lgkmcnt(" #n ")" ::: "memory")
#define PG8_BAR __builtin_amdgcn_s_barrier()
#define PG8_SCHED __builtin_amdgcn_sched_barrier(0)
    Unit cur, nxt; int ui = 0;
    if (!S.next(0, cur)) return;
    f32x4 acc[2][2][4][2];
#pragma unroll
    for (int a = 0; a < 2; ++a)
#pragma unroll
        for (int b = 0; b < 2; ++b)
#pragma unroll
            for (int m = 0; m < 4; ++m)
#pragma unroll
                for (int n = 0; n < 2; ++n) acc[a][b][m][n] = (f32x4){0.f, 0.f, 0.f, 0.f};
    bf16x8 At[4][2], B0[2][2], B1[2][2];
    const char* cA = (const char*)g.A + (size_t)cur.pm * tstep; const char* cB = (const char*)g.Bt + (size_t)cur.pn * tstep;
    S.a_ready(cur);
    if constexpr (SP2) {
        PG8_STAGE(PG8_SB(0, 0), cB, voffB); PG8_STAGE(PG8_SB(0, 1), cB + hstep, voffB); PG8_STAGE(PG8_SA(0, 0), cA, voffA); PG8_STAGE(PG8_SA(0, 1), cA + hstep, voffA);
        if (wr == 1) PG8_BAR;
        PG8_WAIT_V(2); PG8_BAR;
        PG8_STAGE(PG8_SB(1, 0), cB + kstep, voffB); PG8_STAGE(PG8_SA(1, 0), cA + kstep, voffA); PG8_STAGE(PG8_SB(1, 1), cB + hstep + kstep, voffB);
        PG8_WAIT_V(6); PG8_BAR;
    } else {
        PG8_STAGE(PG8_SB(0, 0), cB, voffB); PG8_STAGE(PG8_SA(0, 0), cA, voffA); PG8_STAGE(PG8_SB(0, 1), cB + hstep, voffB); PG8_STAGE(PG8_SA(0, 1), cA + hstep, voffA);
        if (wr == 1) PG8_BAR;
        PG8_WAIT_V(4); PG8_BAR;
        PG8_STAGE(PG8_SB(1, 0), cB + kstep, voffB); PG8_STAGE(PG8_SA(1, 0), cA + kstep, voffA); PG8_STAGE(PG8_SB(1, 1), cB + hstep + kstep, voffB);
        PG8_WAIT_V(6); PG8_BAR;
    }
    for (;;) {
        const bool has_next = S.next(ui + 1, nxt);
        const char* nA = has_next ? (const char*)g.A + (size_t)nxt.pm * tstep : cA; const char* nB = has_next ? (const char*)g.Bt + (size_t)nxt.pn * tstep : cB;
        for (int t = 0; t < nt; t += 2) {
            const bool last = (t == nt - 2);
            const char* a1 = cA + (size_t)(t + 1) * kstep;
            const char* a2 = last ? nA : cA + (size_t)(t + 2) * kstep; const char* b2 = last ? nB : cB + (size_t)(t + 2) * kstep;
            const char* a3 = a2 + kstep; const char* b3 = b2 + kstep;
            if (last && has_next) S.a_ready(nxt);
            if constexpr (SP2) {
            PG8_LDB(B0, 0, 0); PG8_LDB(B1, 0, 1); PG8_SCHED; PG8_LDA(At, 0, 0); PG8_STAGE(PG8_SA(1, 1), a1 + hstep, voffA);
            PG8_WAIT_V(8); PG8_WAIT_L(0); PG8_BAR; PG8_MMA(0, 0, At, B0); PG8_MMA(0, 1, At, B1); PG8_BAR; PG8_SCHED;
            PG8_LDA(At, 0, 1); PG8_STAGE(PG8_SB(0, 0), b2, voffB); PG8_STAGE(PG8_SB(0, 1), b2 + hstep, voffB); PG8_STAGE(PG8_SA(0, 0), a2, voffA);
            PG8_WAIT_V(8); PG8_WAIT_L(0); PG8_BAR; PG8_MMA(1, 0, At, B0); PG8_MMA(1, 1, At, B1); PG8_BAR; PG8_SCHED;
            PG8_LDB(B0, 1, 0); PG8_LDB(B1, 1, 1); PG8_SCHED; PG8_LDA(At, 1, 0); PG8_STAGE(PG8_SA(0, 1), a2 + hstep, voffA);
            PG8_WAIT_V(8); PG8_WAIT_L(0); PG8_BAR; PG8_MMA(0, 0, At, B0); PG8_MMA(0, 1, At, B1); PG8_BAR; PG8_SCHED;
            PG8_LDA(At, 1, 1); PG8_STAGE(PG8_SB(1, 0), b3, voffB); PG8_STAGE(PG8_SB(1, 1), b3 + hstep, voffB); PG8_STAGE(PG8_SA(1, 0), a3, voffA);
            PG8_WAIT_V(8); PG8_WAIT_L(0); PG8_BAR; PG8_MMA(1, 0, At, B0); PG8_MMA(1, 1, At, B1); PG8_BAR; PG8_SCHED;
            } else {
            PG8_LDB(B0, 0, 0); PG8_SCHED; PG8_LDA(At, 0, 0); PG8_STAGE(PG8_SA(1, 1), a1 + hstep, voffA);
            PG8_WAIT_L(8); PG8_BAR; PG8_WAIT_L(0); PG8_MMA(0, 0, At, B0); PG8_BAR; PG8_SCHED;
            PG8_LDB(B1, 0, 1); PG8_STAGE(PG8_SB(0, 0), b2, voffB);
            PG8_BAR; PG8_WAIT_L(0); PG8_MMA(0, 1, At, B1); PG8_BAR;
            PG8_LDA(At, 0, 1); PG8_STAGE(PG8_SA(0, 0), a2, voffA);
            PG8_BAR; PG8_WAIT_L(0); PG8_MMA(1, 0, At, B0); PG8_BAR; PG8_SCHED;
            PG8_STAGE(PG8_SB(0, 1), b2 + hstep, voffB);
            PG8_WAIT_V(6); PG8_BAR; PG8_MMA(1, 1, At, B1); PG8_BAR;
            PG8_LDB(B0, 1, 0); PG8_SCHED; PG8_LDA(At, 1, 0); PG8_STAGE(PG8_SA(0, 1), a2 + hstep, voffA);
            PG8_WAIT_L(8); PG8_BAR; PG8_WAIT_L(0); PG8_MMA(0, 0, At, B0); PG8_BAR; PG8_SCHED;
            PG8_LDB(B1, 1, 1); PG8_STAGE(PG8_SB(1, 0), b3, voffB);
            PG8_BAR; PG8_WAIT_L(0); PG8_MMA(0, 1, At, B1); PG8_BAR;
            PG8_LDA(At, 1, 1); PG8_STAGE(PG8_SA(1, 0), a3, voffA);
            PG8_BAR; PG8_WAIT_L(0); PG8_MMA(1, 0, At, B0); PG8_BAR; PG8_SCHED;
            PG8_STAGE(PG8_SB(1, 1), b3 + hstep, voffB);
            PG8_WAIT_V(6); PG8_BAR; PG8_MMA(1, 1, At, B1); PG8_BAR;
            }
        }
        if constexpr (ALIGN_EPI) { if (wr == 0) PG8_BAR; }
        if constexpr (!Epi::AFTER_DRAIN) { E(acc, cur, wr, wc, fr, fq); S.done(cur); }
        if (!has_next) break;
#pragma unroll
        for (int a = 0; a < 2; ++a)
#pragma unroll
            for (int b = 0; b < 2; ++b)
#pragma unroll
                for (int m = 0; m < 4; ++m)
#pragma unroll
                    for (int n = 0; n < 2; ++n) acc[a][b][m][n] = (f32x4){0.f, 0.f, 0.f, 0.f};
        cur = nxt; cA = nA; cB = nB; ++ui;
        if constexpr (ALIGN_EPI) { if (wr == 1) PG8_BAR; }
    }
    PG8_WAIT_V(0);
    if constexpr (!ALIGN_EPI) { if (wr == 0) PG8_BAR; }
    PG8_BAR;
    if constexpr (Epi::AFTER_DRAIN) { E.fused(acc, cur, wr, wc, fr, fq, lds, wid, lane); S.done(cur); }
#undef PG8_SA
#undef PG8_SB
#undef PG8_STAGE
#undef PG8_LDA
#undef PG8_LDB
#undef PG8_MMA
#undef PG8_WAIT_V
#undef PG8_WAIT_L
#undef PG8_BAR
#undef PG8_SCHED
}
}

#define GAS __attribute__((address_space(1)))
#define LAS __attribute__((address_space(3)))
typedef unsigned short bf16;
typedef unsigned v4u __attribute__((ext_vector_type(4)));
typedef float f32x4 __attribute__((ext_vector_type(4)));
typedef short bf16x8 __attribute__((ext_vector_type(8)));
typedef GAS unsigned gu32;
typedef GAS unsigned long long gu64;
#define RLX_AGENT __ATOMIC_RELAXED, __HIP_MEMORY_SCOPE_AGENT
#define LDS_WAIT() asm volatile("s_waitcnt lgkmcnt(0)" ::: "memory")
#define VM_WAIT() asm volatile("s_waitcnt vmcnt(0)" ::: "memory")
__device__ __forceinline__ unsigned long long rt() { return __builtin_amdgcn_s_memrealtime(); }
__device__ __forceinline__ unsigned f2bf(float f) { unsigned u = __builtin_bit_cast(unsigned, f); return (u + 0x7fffu + ((u >> 16) & 1u)) >> 16; }
__device__ __forceinline__ unsigned pk2(float lo, float hi) { return f2bf(lo) | (f2bf(hi) << 16); }

#define XB_TMO      128
#define XB_XCNT(j)  (256  + 64 * (j))
#define XB_XSUB(j)  (1280 + 64 * (j))
#define XB_XGEN(j)  (2304 + 64 * (j))
#define XB_TOP      3328
#define XB_TOPGEN   3392
#define XCD_BAR_WORDS 3456
#define XB_SPIN_CAP (1u << 18)

__device__ __forceinline__ unsigned xb_ld(unsigned* p)              { return __hip_atomic_load(p, __ATOMIC_RELAXED, __HIP_MEMORY_SCOPE_AGENT); }
__device__ __forceinline__ unsigned xb_add(unsigned* p, unsigned v) { return __hip_atomic_fetch_add(p, v, __ATOMIC_RELAXED, __HIP_MEMORY_SCOPE_AGENT); }
__device__ __forceinline__ unsigned xb_xcc_id() { return (unsigned)__builtin_amdgcn_s_getreg((3 << 11) | 20) & 0xFu; }
#define XB_SPIN(cond, bar) do { unsigned _sp = 0; while (cond) { __builtin_amdgcn_s_sleep(1); \
    if ((++_sp & 255u) == 0u) { if (xb_ld(&(bar)[XB_TMO])) break; if (_sp > XB_SPIN_CAP) { atomicAdd(&(bar)[XB_TMO], 1u); break; } } } } while (0)

struct XcdBarrier {
    unsigned* bar; unsigned x;
    volatile LAS unsigned* st;
};

__device__ __forceinline__ XcdBarrier xcd_barrier_post(unsigned* bar, volatile LAS unsigned* st) {
    XcdBarrier b; b.bar = bar; b.x = xb_xcc_id(); b.st = st;
    if (threadIdx.x == 0) (void)xb_add(&bar[XB_XCNT(b.x)], 1u);
    return b;
}
__device__ __forceinline__ void xcd_barrier_complete(unsigned* bar, unsigned x, unsigned& nloc, unsigned& nx) {
    const unsigned G = gridDim.x * gridDim.y * gridDim.z;
    unsigned sum, cnt, mine, sp = 0u;
    for (;;) {
        sum = 0u; cnt = 0u; mine = 0u;
#pragma unroll
        for (unsigned j = 0; j < 16; ++j) { const unsigned c = xb_ld(&bar[XB_XCNT(j)]); sum += c; cnt += (c > 0u) ? 1u : 0u; mine = (j == x) ? c : mine; }
        if (sum == G) break;
        __builtin_amdgcn_s_sleep(1);
        if ((++sp & 255u) == 0u) { if (xb_ld(&bar[XB_TMO])) break; if (sp > XB_SPIN_CAP) { atomicAdd(&bar[XB_TMO], 1u); break; } }
    }
    nloc = mine > 0u ? mine : 1u; nx = cnt > 0u ? cnt : 1u;
}

__device__ __forceinline__ void xcd_barrier(const XcdBarrier& b) {
    asm volatile("s_waitcnt vmcnt(0)" ::: "memory");
    __syncthreads();
    if (threadIdx.x == 0) {
        unsigned* bar = b.bar;
        __builtin_amdgcn_s_waitcnt(0);
        unsigned nloc = b.st[0], nx = b.st[1];
        if (nloc == 0u) { xcd_barrier_complete(bar, b.x, nloc, nx); b.st[0] = nloc; b.st[1] = nx; }
        const unsigned old = xb_add(&bar[XB_XSUB(b.x)], 1u);
        const unsigned gen = old / nloc;
        if (old + 1u == (gen + 1u) * nloc) {
            __builtin_amdgcn_fence(__ATOMIC_RELEASE, "agent");
            asm volatile("s_waitcnt vmcnt(0)" ::: "memory");
            const unsigned og = xb_add(&bar[XB_TOP], 1u);
            const unsigned tg = og / nx;
            if (og + 1u == (tg + 1u) * nx) xb_add(&bar[XB_TOPGEN], 1u);
            else XB_SPIN(xb_ld(&bar[XB_TOPGEN]) == tg, bar);
            __builtin_amdgcn_fence(__ATOMIC_ACQUIRE, "agent");
            xb_add(&bar[XB_XGEN(b.x)], 1u);
            asm volatile("s_waitcnt vmcnt(0)" ::: "memory");
        } else {
            XB_SPIN(xb_ld(&bar[XB_XGEN(b.x)]) == gen, bar);
            __builtin_amdgcn_fence(__ATOMIC_ACQUIRE, "agent");
            asm volatile("s_waitcnt vmcnt(0)" ::: "memory");
        }
    }
    __syncthreads();
}

constexpr int NWAVES = 8;
#ifndef MK_N_LAUNCHES
#define MK_N_LAUNCHES 1
#endif
constexpr int N_PHASES = 12;
constexpr int D = 4096, SEQ = 2048, NB = 8, NSB = 16, NST = 16, PAST = 4096;
constexpr int NP = NB * SEQ;
constexpr int M = NP + NSB * NST;
constexpr int IN0 = 8704, IN1 = 16448, IN1M = 16384, IN1P = 16640, DFF = 16384;
constexpr int C_K = 2048, C_V = 2304, C_B = 2560, C_C = 4608, C_X = 6656;
constexpr int NH = 32, HD = 64, NKV = 4, GDH = 128, QKV = 12288;
constexpr size_t MiB = 1u << 20;
constexpr size_t WS_CTL = 0, CTL_ZERO_BYTES = 2 * MiB;
constexpr size_t WS_SSQ = 1 * MiB;
constexpr size_t WS_ROPE = 2 * MiB;
constexpr size_t WS_AUX = 3 * MiB;
constexpr size_t WS_WINA = 8 * MiB;
constexpr size_t WS_WOUTA = WS_WINA + 68 * MiB;
constexpr size_t WS_WING = WS_WOUTA + 32 * MiB;
constexpr size_t WS_WOUTG = WS_WING + 130 * MiB;
constexpr size_t WS_WUP = WS_WOUTG + 32 * MiB;
constexpr size_t WS_WDN = WS_WUP + 256 * MiB;
constexpr size_t WS_XB = WS_WDN + 256 * MiB;
constexpr size_t WS_MIX = WS_XB + 130 * MiB;
constexpr size_t WS_XRES = WS_MIX + 130 * MiB;
constexpr size_t WS_BIG = WS_XRES + 260 * MiB;
constexpr size_t WS_END = WS_BIG + 520 * MiB;
static_assert((size_t)M * D * 2 <= 130 * MiB && (size_t)M * D * 4 <= 260 * MiB && (size_t)M * DFF * 2 <= 520 * MiB && (size_t)IN1P * D * 2 <= 130 * MiB, "ws map");
constexpr int CW_BAR = 4096;
constexpr int RING_BYTES = 131072;
constexpr int LDS_BYTES = 147456;
constexpr int MISC_OFF = LDS_BYTES - 256;
constexpr int SMALL_OFF = 133120;

typedef float f32x4v __attribute__((ext_vector_type(4)));
constexpr float RMS6 = 1e-6f;
__device__ __forceinline__ float bf2f(unsigned short b) { return __builtin_bit_cast(float, (unsigned)b << 16); }
__device__ __forceinline__ void unpack8(const v4u w, float* f) {
    f[0] = __builtin_bit_cast(float, w.x << 16); f[1] = __builtin_bit_cast(float, w.x & 0xffff0000u);
    f[2] = __builtin_bit_cast(float, w.y << 16); f[3] = __builtin_bit_cast(float, w.y & 0xffff0000u);
    f[4] = __builtin_bit_cast(float, w.z << 16); f[5] = __builtin_bit_cast(float, w.z & 0xffff0000u);
    f[6] = __builtin_bit_cast(float, w.w << 16); f[7] = __builtin_bit_cast(float, w.w & 0xffff0000u);
}
__device__ __forceinline__ v4u pack8(const float* f) { v4u o; o.x = pk2(f[0], f[1]); o.y = pk2(f[2], f[3]); o.z = pk2(f[4], f[5]); o.w = pk2(f[6], f[7]); return o; }
__device__ __forceinline__ float wave_sum(float v) {
#pragma unroll
    for (int o = 1; o < 64; o <<= 1) v += __shfl_xor(v, o);
    return v;
}
__device__ __forceinline__ float siluf(float x) { return x / (1.0f + __expf(-x)); }

struct Args { const float* in[23]; float* out; unsigned char* ws; int ph_lo, ph_hi; };
enum { I_XP = 0, I_XS, I_CK, I_CV, I_SSC, I_SDC, I_SDN, I_ANORM, I_WINA, I_SINKS, I_SCW, I_WOUTA, I_DNORM, I_WING, I_DCW, I_ALOG, I_DTB, I_ONW, I_WOUTG, I_MNORM, I_WUP, I_WDN, I_FNORM };
constexpr size_t O_Y = 0;
constexpr size_t O_KP = (size_t)M * D;
constexpr size_t O_VP = O_KP + 8 * 128 * 256;
constexpr size_t O_KS = O_VP + 8 * 128 * 256;
constexpr size_t O_VS = O_KS + 16 * 128 * 256;
constexpr size_t O_CP = O_VS + 16 * 128 * 256;
constexpr size_t O_CS = O_CP + 8 * 2 * 2048;
constexpr size_t O_DCP = O_CS + 16 * 2 * 2048;
constexpr size_t O_DCS = O_DCP + 8 * 3 * 12288;
constexpr size_t O_DSP = O_DCS + 16 * 3 * 12288;
constexpr size_t O_DSS = O_DSP + (size_t)8 * 32 * 128 * 128;
constexpr size_t O_END = O_DSS + (size_t)16 * 32 * 128 * 128;

struct Frame {
    LAS unsigned char* lds; int tid, lane, wave, vcu, G;
};

__device__ __forceinline__ void p0_item(const float* W, int ldw, const float* gain, bf16* WT, int K, int k0, int n0, LAS float* scr, int lane) {
#pragma unroll 4
    for (int i = 0; i < 16; ++i) { const int kk = 4 * i + (lane >> 4);
        f32x4v v = *(const f32x4v*)(W + (size_t)(k0 + kk) * ldw + n0 + 4 * (lane & 15));
        const float g = gain ? gain[k0 + kk] : 1.0f; LAS float* s = scr + kk * 65 + 4 * (lane & 15);
        s[0] = v.x * g; s[1] = v.y * g; s[2] = v.z * g; s[3] = v.w * g; }
    LDS_WAIT(); asm volatile("" ::: "memory");
    const int c = lane & 7;
#pragma unroll
    for (int j = 0; j < 8; ++j) { const int n = (lane >> 3) + 8 * j; const LAS float* s = scr + (8 * c) * 65 + n;
        v4u o; o.x = pk2(s[0 * 65], s[1 * 65]); o.y = pk2(s[2 * 65], s[3 * 65]); o.z = pk2(s[4 * 65], s[5 * 65]); o.w = pk2(s[6 * 65], s[7 * 65]);
        *(GAS v4u*)(WT + (size_t)(n0 + n) * K + k0 + 8 * c) = o; }
    LDS_WAIT(); asm volatile("" ::: "memory");
}
__device__ __forceinline__ double rope_inv(int i) {
    return i == 0 ? 1.0 : i == 1 ? 0.19392274474868576 : i == 2 ? 0.03760603093086393 : i == 3 ? 0.007292664737217109 : i == 4 ? 0.001414213562373095 :
           i == 5 ? 0.0002742481756762073 : i == 6 ? 5.318295896944988e-05 : 1.031338537721246e-05;
}
__device__ __forceinline__ void p0_prologue(const Frame& F, const Args& a) {
    unsigned char* ws = a.ws;
    LAS float* scr = (LAS float*)(F.lds + F.wave * 16640);
    const int gw = F.vcu * NWAVES + F.wave, NGW = F.G * NWAVES;
    constexpr int I0 = 64 * 136, I1 = 64 * 64, I2 = 64 * 257, I3 = 64 * 64, I4 = 2 * 64 * 256, I5 = 2 * 256 * 64;
    constexpr int NIT = I0 + I1 + I2 + I3 + I4 + I5;
    for (int it = gw; it < NIT; it += NGW) {
        int r = it;
        if (r < I0) { p0_item(a.in[I_WINA], IN0, a.in[I_ANORM], (bf16*)(ws + WS_WINA), D, 64 * (r / 136), 64 * (r % 136), scr, F.lane); continue; } r -= I0;
        if (r < I1) { p0_item(a.in[I_WOUTA], D, nullptr, (bf16*)(ws + WS_WOUTA), D, 64 * (r / 64), 64 * (r % 64), scr, F.lane); continue; } r -= I1;
        if (r < I2) { p0_item(a.in[I_WING], IN1, a.in[I_DNORM], (bf16*)(ws + WS_WING), D, 64 * (r / 257), 64 * (r % 257), scr, F.lane); continue; } r -= I2;
        if (r < I3) { p0_item(a.in[I_WOUTG], D, nullptr, (bf16*)(ws + WS_WOUTG), D, 64 * (r / 64), 64 * (r % 64), scr, F.lane); continue; } r -= I3;
        if (r < I4) { const int l = r / (64 * 256); r -= l * 64 * 256;
            p0_item(a.in[I_WUP] + (size_t)l * D * DFF, DFF, a.in[I_MNORM] + l * D, (bf16*)(ws + WS_WUP) + (size_t)l * DFF * D, D, 64 * (r / 256), 64 * (r % 256), scr, F.lane); continue; } r -= I4;
        { const int l = r / (256 * 64); r -= l * 256 * 64;
            p0_item(a.in[I_WDN] + (size_t)l * DFF * D, D, nullptr, (bf16*)(ws + WS_WDN) + (size_t)l * D * DFF, DFF, 64 * (r / 64), 64 * (r % 64), scr, F.lane); }
    }
    { GAS v4u* z = (GAS v4u*)((bf16*)(ws + WS_WING) + (size_t)IN1 * D); const int nz = (IN1P - IN1) * D / 8;
      for (int i = gw * 64 + F.lane; i < nz; i += NGW * 64) z[i] = (v4u){0u, 0u, 0u, 0u}; }
    float* ssq0 = (float*)(ws + WS_SSQ);
    for (int m = gw; m < M; m += NGW) {
        const float* xr = (m < NP) ? a.in[I_XP] + (size_t)m * D : a.in[I_XS] + (size_t)(m - NP) * D;
        bf16* ob = (bf16*)(ws + WS_XB) + (size_t)m * D;
        float s = 0.f;
#pragma unroll
        for (int j = 0; j < 8; ++j) {
            const f32x4v v0 = *(const f32x4v*)(xr + j * 512 + F.lane * 8), v1 = *(const f32x4v*)(xr + j * 512 + F.lane * 8 + 4);
            s += (v0.x * v0.x + v0.y * v0.y) + (v0.z * v0.z + v0.w * v0.w) + (v1.x * v1.x + v1.y * v1.y) + (v1.z * v1.z + v1.w * v1.w);
            v4u o; o.x = pk2(v0.x, v0.y); o.y = pk2(v0.z, v0.w); o.z = pk2(v1.x, v1.y); o.w = pk2(v1.z, v1.w);
            *(GAS v4u*)(ob + j * 512 + F.lane * 8) = o;
        }
        s = wave_sum(s);
        if (F.lane == 0) ssq0[m] = s;
    }
    float* rope = (float*)(ws + WS_ROPE);
    for (int i = (F.vcu * NWAVES * 64) + F.tid; i < 2064 * 8; i += F.G * NWAVES * 64) {
        const int pi = i >> 3, fi = i & 7; const int pos = pi < 2048 ? pi : PAST + (pi - 2048);
        const float angf = (float)pos * (float)rope_inv(fi);
        double rev = (double)angf * 0.15915494309189535; rev -= __builtin_rint(rev);
        const float r = (float)rev;
        rope[pi * 16 + fi] = __builtin_amdgcn_cosf(r); rope[pi * 16 + 8 + fi] = __builtin_amdgcn_sinf(r);
    }
}

__device__ __forceinline__ void rope8(float* mine, const float* other, const float* cs, bool second) {
#pragma unroll
    for (int i = 0; i < 8; ++i) mine[i] = second ? (mine[i] * cs[i] + other[i] * cs[8 + i]) : (mine[i] * cs[i] - other[i] * cs[8 + i]);
}
__device__ __forceinline__ void attn_phase(const Frame& F, const Args& a) {
    unsigned char* ws = a.ws;
    const bf16* proj = (const bf16*)(ws + WS_BIG); bf16* mix = (bf16*)(ws + WS_MIX);
    const float* rope = (const float*)(ws + WS_ROPE);
    LAS float* Kf = (LAS float*)F.lds; LAS float* Vf = Kf + 192 * 64;
    const int tid = F.tid, lane = F.lane, w = F.wave;
    constexpr int NU = 1024 + 64;
    for (int u = F.vcu; u < NU; u += F.G) {
        const bool samp = u >= 1024;
        int n, c, kvh, j0, j1;
        if (!samp) { n = u >> 7; c = (u >> 2) & 31; kvh = u & 3; j0 = c >= 2 ? 0 : (2 - c) * 64; j1 = 192; }
        else { const int v = u - 1024; n = v >> 2; c = 0; kvh = v & 3; j0 = 0; j1 = 144; }
        __syncthreads();
#pragma unroll 1
        for (int it = 0; it < 3; ++it) {
            const int slot = it * 512 + tid, j = slot >> 3, ch = slot & 7;
            float kf[8], vf[8]; bool rot = false; int pi = 0;
#pragma unroll
            for (int i = 0; i < 8; ++i) { kf[i] = 0.f; vf[i] = 0.f; }
            if (!samp) {
                const int pos = (c - 2) * 64 + j;
                if (pos >= 0) { const bf16* r = proj + ((size_t)n * SEQ + pos) * IN0 + kvh * 64 + ch * 8;
                    unpack8(*(const GAS v4u*)(r + C_K), kf); unpack8(*(const GAS v4u*)(r + C_V), vf); rot = true; pi = pos; }
            } else {
                if (j < 128) { const size_t o = (((size_t)n * 128 + j) * 4 + kvh) * 64 + ch * 8;
                    const f32x4v k0 = *(const f32x4v*)(a.in[I_CK] + o), k1 = *(const f32x4v*)(a.in[I_CK] + o + 4), v0 = *(const f32x4v*)(a.in[I_CV] + o), v1 = *(const f32x4v*)(a.in[I_CV] + o + 4);
                    kf[0] = k0.x; kf[1] = k0.y; kf[2] = k0.z; kf[3] = k0.w; kf[4] = k1.x; kf[5] = k1.y; kf[6] = k1.z; kf[7] = k1.w;
                    vf[0] = v0.x; vf[1] = v0.y; vf[2] = v0.z; vf[3] = v0.w; vf[4] = v1.x; vf[5] = v1.y; vf[6] = v1.z; vf[7] = v1.w; }
                else if (j < 144) { const bf16* r = proj + ((size_t)NP + n * NST + (j - 128)) * IN0 + kvh * 64 + ch * 8;
                    unpack8(*(const GAS v4u*)(r + C_K), kf); unpack8(*(const GAS v4u*)(r + C_V), vf); rot = true; pi = 2048 + (j - 128); }
            }
            float ot[8];
#pragma unroll
            for (int i = 0; i < 8; ++i) ot[i] = __shfl_xor(kf[i], 1);
            if (rot && ch < 2) { float cs[16];
#pragma unroll
                for (int i = 0; i < 4; ++i) { const f32x4v t = *(const f32x4v*)(rope + pi * 16 + 4 * i); cs[4 * i] = t.x; cs[4 * i + 1] = t.y; cs[4 * i + 2] = t.z; cs[4 * i + 3] = t.w; }
                rope8(kf, ot, cs, ch == 1); }
            LAS f32x4v* kd = (LAS f32x4v*)(Kf + j * 64 + ch * 8); LAS f32x4v* vd = (LAS f32x4v*)(Vf + j * 64 + ch * 8);
            kd[0] = (f32x4v){kf[0], kf[1], kf[2], kf[3]}; kd[1] = (f32x4v){kf[4], kf[5], kf[6], kf[7]};
            vd[0] = (f32x4v){vf[0], vf[1], vf[2], vf[3]}; vd[1] = (f32x4v){vf[4], vf[5], vf[6], vf[7]};
            int p = -1; float* ko = nullptr; float* vo = nullptr;
            if (!samp) { if (c == 31 && j >= 64) { p = j - 64; ko = a.out + O_KP; vo = a.out + O_VP; } }
            else { if (j >= 16 && j < 144) { p = j - 16; ko = a.out + O_KS; vo = a.out + O_VS; } }
            if (p >= 0) { const size_t o = (((size_t)n * 128 + p) * 4 + kvh) * 64 + ch * 8;
                *(f32x4v*)(ko + o) = (f32x4v){kf[0], kf[1], kf[2], kf[3]}; *(f32x4v*)(ko + o + 4) = (f32x4v){kf[4], kf[5], kf[6], kf[7]};
                *(f32x4v*)(vo + o) = (f32x4v){vf[0], vf[1], vf[2], vf[3]}; *(f32x4v*)(vo + o + 4) = (f32x4v){vf[4], vf[5], vf[6], vf[7]}; }
        }
        __syncthreads();
        const int head = kvh * 8 + w, hf2 = lane & 1;
        const float sinkv = a.in[I_SINKS][head];
        for (int ps = 0; ps < (samp ? 1 : 2); ++ps) {
            const int ql = ps * 32 + (lane >> 1);
            const bool act = samp ? (ql < NST) : true;
            const size_t qr = samp ? (size_t)NP + n * NST + (ql & 15) : (size_t)n * SEQ + c * 64 + ql;
            const int qpi2 = samp ? 2048 + (ql & 15) : c * 64 + ql;
            float q[32];
            { const bf16* qp = proj + qr * IN0 + head * 64 + hf2 * 32;
#pragma unroll
              for (int i = 0; i < 4; ++i) unpack8(*(const GAS v4u*)(qp + 8 * i), q + 8 * i);
              if (hf2 == 0) { float cs[16];
#pragma unroll
                for (int i = 0; i < 4; ++i) { const f32x4v t = *(const f32x4v*)(rope + qpi2 * 16 + 4 * i); cs[4 * i] = t.x; cs[4 * i + 1] = t.y; cs[4 * i + 2] = t.z; cs[4 * i + 3] = t.w; }
#pragma unroll
                for (int i = 0; i < 8; ++i) { const float x1 = q[i], x2 = q[8 + i]; q[i] = x1 * cs[i] - x2 * cs[8 + i]; q[8 + i] = x2 * cs[i] + x1 * cs[8 + i]; } }
#pragma unroll
              for (int i = 0; i < 32; ++i) q[i] *= 0.125f; }
            float mx = sinkv, l = 1.0f; float o[32];
#pragma unroll
            for (int i = 0; i < 32; ++i) o[i] = 0.f;
            for (int jb = j0; jb < j1; jb += 4) {
                float s[4];
#pragma unroll
                for (int jj = 0; jj < 4; ++jj) { const LAS f32x4v* kr = (const LAS f32x4v*)(Kf + (jb + jj) * 64 + hf2 * 32); float acc = 0.f;
#pragma unroll
                    for (int i = 0; i < 8; ++i) { const f32x4v k4 = kr[i]; acc += q[4 * i] * k4.x + q[4 * i + 1] * k4.y + q[4 * i + 2] * k4.z + q[4 * i + 3] * k4.w; }
                    s[jj] = acc + __shfl_xor(acc, 1); }
                const float mn = fmaxf(fmaxf(mx, fmaxf(s[0], s[1])), fmaxf(s[2], s[3]));
                const float corr = __expf(mx - mn); mx = mn; l *= corr;
#pragma unroll
                for (int i = 0; i < 32; ++i) o[i] *= corr;
#pragma unroll
                for (int jj = 0; jj < 4; ++jj) { const float p = __expf(s[jj] - mn); l += p; const LAS f32x4v* vr = (const LAS f32x4v*)(Vf + (jb + jj) * 64 + hf2 * 32);
#pragma unroll
                    for (int i = 0; i < 8; ++i) { const f32x4v v4 = vr[i]; o[4 * i] += p * v4.x; o[4 * i + 1] += p * v4.y; o[4 * i + 2] += p * v4.z; o[4 * i + 3] += p * v4.w; } }
            }
            if (act) { const float il = 1.0f / l; bf16* op = mix + qr * D + head * 64 + hf2 * 32;
#pragma unroll
                for (int i = 0; i < 4; ++i) { float t[8];
#pragma unroll
                    for (int k = 0; k < 8; ++k) t[k] = o[8 * i + k] * il;
                    *(GAS v4u*)(op + 8 * i) = pack8(t); } }
        }
    }
    {
        const float* cw = a.in[I_SCW];
        const int cg = tid & 255, hf = tid >> 8, ch0 = cg * 8;
        float w0[8], w1[8], w2[8];
#pragma unroll
        for (int i = 0; i < 8; ++i) { w0[i] = cw[ch0 + i]; w1[i] = cw[2048 + ch0 + i]; w2[i] = cw[4096 + ch0 + i]; }
        for (int u = F.vcu; u < 512 + 16; u += F.G) {
            int T, ta, tb; size_t rowb; const float* st = nullptr; float* so;
            if (u < 512) { const int n = u >> 6, seg = u & 63; T = SEQ; rowb = (size_t)n * SEQ; ta = seg * 32 + hf * 16; tb = ta + 16; so = a.out + O_CP + (size_t)n * 2 * 2048; }
            else { const int n = u - 512; T = NST; rowb = (size_t)NP + n * NST; ta = hf * 8; tb = ta + 8; st = a.in[I_SSC] + (size_t)n * 2 * 2048; so = a.out + O_CS + (size_t)n * 2 * 2048; }
            float um2[8], um1[8];
#pragma unroll
            for (int i = 0; i < 8; ++i) { um2[i] = 0.f; um1[i] = 0.f; }
            for (int t = ta - 2; t < tb; ++t) {
                float uc[8], bg[8];
                if (t >= 0) { const bf16* r = proj + (rowb + t) * IN0 + ch0; float cgv[8], xv[8];
                    unpack8(*(const GAS v4u*)(r + C_C), cgv); unpack8(*(const GAS v4u*)(r + C_X), xv); unpack8(*(const GAS v4u*)(r + C_B), bg);
#pragma unroll
                    for (int i = 0; i < 8; ++i) uc[i] = cgv[i] * xv[i]; }
                else {
#pragma unroll
                    for (int i = 0; i < 8; ++i) { uc[i] = st ? st[(size_t)(2 + t) * 2048 + ch0 + i] : 0.f; bg[i] = 0.f; } }
                if (t >= ta) { float z[8];
#pragma unroll
                    for (int i = 0; i < 8; ++i) z[i] = bg[i] * (w0[i] * um2[i] + w1[i] * um1[i] + w2[i] * uc[i]);
                    *(GAS v4u*)(mix + (rowb + t) * D + 2048 + ch0) = pack8(z); }
                if (t >= T - 2 && t >= ta) { float* o = so + (size_t)(t - (T - 2)) * 2048 + ch0;
                    *(f32x4v*)o = (f32x4v){uc[0], uc[1], uc[2], uc[3]}; *(f32x4v*)(o + 4) = (f32x4v){uc[4], uc[5], uc[6], uc[7]}; }
#pragma unroll
                for (int i = 0; i < 8; ++i) { um2[i] = um1[i]; um1[i] = uc[i]; }
            }
        }
    }
}

__device__ __forceinline__ void gdn_phase(const Frame& F, const Args& a) {
    unsigned char* ws = a.ws;
    const bf16* proj = (const bf16*)(ws + WS_BIG); const float* aux = (const float*)(ws + WS_AUX); bf16* og = (bf16*)(ws + WS_MIX);
    LAS float* qkv = (LAS float*)F.lds;
    LAS float* os = qkv + 64 * 384;
    LAS float* sm = (LAS float*)(F.lds + SMALL_OFF);
    LAS float* ssq = sm; LAS float* egs = sm + 128; LAS float* bes = sm + 192;
    const int tid = F.tid, lane = F.lane, w = F.wave, quarter = lane >> 4, col = lane & 15;
    const float* cw = a.in[I_DCW];
    for (int ch = F.vcu; ch < 256 + 512; ch += F.G) {
        const bool samp = ch >= 256;
        int n, h, T, TB; size_t rowb;
        if (!samp) { n = ch >> 5; h = ch & 31; T = SEQ; TB = 64; rowb = (size_t)n * SEQ; }
        else { const int v = ch - 256; n = v >> 5; h = v & 31; T = NST; TB = 16; rowb = (size_t)NP + n * NST; }
        const float Aexp = __expf(a.in[I_ALOG][h]), dtb = a.in[I_DTB][h];
        float S[32];
        if (samp) { const float* s0 = a.in[I_SDN] + (((size_t)n * 32 + h) * 128) * 128;
#pragma unroll
            for (int i = 0; i < 32; ++i) S[i] = s0[(size_t)(quarter * 32 + i) * 128 + 16 * w + col]; }
        else {
#pragma unroll
            for (int i = 0; i < 32; ++i) S[i] = 0.f; }
        const int cg = tid % 48, rg = tid / 48, part = cg >> 4, c0 = (cg & 15) * 8, gch = part * 4096 + h * 128 + c0;
        for (int t0 = 0; t0 < T; t0 += TB) {
            __syncthreads();
            if (tid < 128) ssq[tid] = 0.f;
            __syncthreads();
            if (rg < 10) {
                float cwv[4][8];
#pragma unroll
                for (int i = 0; i < 4; ++i)
#pragma unroll
                    for (int k = 0; k < 8; ++k) cwv[i][k] = cw[(size_t)i * QKV + gch + k];
                float w0[8], w1[8], w2[8];
#pragma unroll
                for (int k = 0; k < 8; ++k) { w0[k] = 0.f; w1[k] = 0.f; w2[k] = 0.f; }
#pragma unroll
                for (int r = 0; r < 10; ++r) { const int t = t0 + rg * 7 + r - 3; float cur[8];
                    if (t >= 0 && t < T) unpack8(*(const GAS v4u*)(proj + (rowb + t) * IN1M + gch), cur);
                    else if (t < 0 && samp) { const float* sp = a.in[I_SDC] + ((size_t)n * 3 + (3 + t)) * QKV + gch;
#pragma unroll
                        for (int k = 0; k < 8; ++k) cur[k] = sp[k]; }
                    else {
#pragma unroll
                        for (int k = 0; k < 8; ++k) cur[k] = 0.f; }
                    if (r >= 3) { const int lr = rg * 7 + r - 3;
                        if (t >= T - 3 && t < T) { float* o = a.out + (samp ? O_DCS : O_DCP) + ((size_t)n * 3 + (t - (T - 3))) * QKV + gch;
                            *(f32x4v*)o = (f32x4v){cur[0], cur[1], cur[2], cur[3]}; *(f32x4v*)(o + 4) = (f32x4v){cur[4], cur[5], cur[6], cur[7]}; }
                        float y[8]; float ss = 0.f;
#pragma unroll
                        for (int k = 0; k < 8; ++k) { const float x = cwv[0][k] * w0[k] + cwv[1][k] * w1[k] + cwv[2][k] * w2[k] + cwv[3][k] * cur[k]; y[k] = siluf(x); ss += y[k] * y[k]; }
                        if (lr < TB) { LAS f32x4v* d = (LAS f32x4v*)(qkv + lr * 384 + part * 128 + c0);
                            d[0] = (f32x4v){y[0], y[1], y[2], y[3]}; d[1] = (f32x4v){y[4], y[5], y[6], y[7]};
                            if (part < 2) __hip_atomic_fetch_add(&ssq[lr * 2 + part], ss, __ATOMIC_RELAXED, __HIP_MEMORY_SCOPE_WORKGROUP); }
                    }
#pragma unroll
                    for (int k = 0; k < 8; ++k) { w0[k] = w1[k]; w1[k] = w2[k]; w2[k] = cur[k]; }
                }
            }
            if (tid < TB) { const float av = aux[(rowb + t0 + tid) * 64 + h], bv = aux[(rowb + t0 + tid) * 64 + 32 + h];
                const float x = av + dtb; const float sp = fmaxf(x, 0.f) + log1pf(__expf(-fabsf(x)));
                egs[tid] = __expf(-Aexp * sp); bes[tid] = 1.0f / (1.0f + __expf(-bv)); }
            __syncthreads();
            if (rg < 10 && part < 2) {
#pragma unroll
                for (int r = 0; r < 7; ++r) { const int lr = rg * 7 + r;
                    if (lr < TB) { const float sc = rsqrtf(ssq[lr * 2 + part] + RMS6) * (part == 0 ? 0.08838834764831845f : 1.0f);
                        LAS f32x4v* d = (LAS f32x4v*)(qkv + lr * 384 + part * 128 + c0);
                        f32x4v x0 = d[0], x1 = d[1]; x0 = x0 * sc; x1 = x1 * sc; d[0] = x0; d[1] = x1; } }
            }
            __syncthreads();
            for (int t = 0; t < TB; ++t) {
                const LAS float* row = qkv + t * 384;
                float kk[32], qq[32];
#pragma unroll
                for (int i = 0; i < 8; ++i) { const f32x4v k4 = *(const LAS f32x4v*)(row + 128 + quarter * 32 + 4 * i), q4 = *(const LAS f32x4v*)(row + quarter * 32 + 4 * i);
                    kk[4 * i] = k4.x; kk[4 * i + 1] = k4.y; kk[4 * i + 2] = k4.z; kk[4 * i + 3] = k4.w; qq[4 * i] = q4.x; qq[4 * i + 1] = q4.y; qq[4 * i + 2] = q4.z; qq[4 * i + 3] = q4.w; }
                const float v = row[256 + 16 * w + col], eg = egs[t], be = bes[t];
                float ks = 0.f;
#pragma unroll
                for (int i = 0; i < 32; ++i) ks += kk[i] * S[i];
                ks += __shfl_xor(ks, 16); ks += __shfl_xor(ks, 32);
                const float uu = be * (v - eg * ks);
                float oo = 0.f;
#pragma unroll
                for (int i = 0; i < 32; ++i) { S[i] = eg * S[i] + kk[i] * uu; oo += qq[i] * S[i]; }
                oo += __shfl_xor(oo, 16); oo += __shfl_xor(oo, 32);
                if (quarter == 0) os[t * 128 + 16 * w + col] = oo;
            }
            __syncthreads();
            { const int r = tid >> 3, j = tid & 7;
              if (r < TB) { float ov[16]; float ss = 0.f;
#pragma unroll
                for (int i = 0; i < 4; ++i) { const f32x4v t4 = *(const LAS f32x4v*)(os + r * 128 + j * 16 + 4 * i); ov[4 * i] = t4.x; ov[4 * i + 1] = t4.y; ov[4 * i + 2] = t4.z; ov[4 * i + 3] = t4.w; ss += (t4.x * t4.x + t4.y * t4.y) + (t4.z * t4.z + t4.w * t4.w); }
                ss += __shfl_xor(ss, 1); ss += __shfl_xor(ss, 2); ss += __shfl_xor(ss, 4);
                const float rs = rsqrtf(ss * (1.0f / 128.0f) + RMS6);
                const size_t row = rowb + t0 + r; float gt[16];
                unpack8(*(const GAS v4u*)(proj + row * IN1M + QKV + h * 128 + j * 16), gt); unpack8(*(const GAS v4u*)(proj + row * IN1M + QKV + h * 128 + j * 16 + 8), gt + 8);
                const float* onw = a.in[I_ONW] + j * 16;
#pragma unroll
                for (int i = 0; i < 16; ++i) ov[i] = ov[i] * rs * onw[i] * siluf(gt[i]);
                *(GAS v4u*)(og + row * D + h * 128 + j * 16) = pack8(ov); *(GAS v4u*)(og + row * D + h * 128 + j * 16 + 8) = pack8(ov + 8); }
            }
        }
        { float* so = a.out + (samp ? O_DSS : O_DSP) + (((size_t)n * 32 + h) * 128) * 128;
#pragma unroll
          for (int i = 0; i < 32; ++i) so[(size_t)(quarter * 32 + i) * 128 + 16 * w + col] = S[i]; }
    }
}

__device__ __forceinline__ void final_phase(const Frame& F, const Args& a) {
    const float* ssq = (const float*)(a.ws + WS_SSQ) + 4 * (size_t)M; const float* g = a.in[I_FNORM];
    const int gw = F.vcu * NWAVES + F.wave, NGW = F.G * NWAVES;
    for (int m = gw; m < M; m += NGW) {
        float* yr = a.out + O_Y + (size_t)m * D; const float rs = rsqrtf(ssq[m] * (1.0f / D) + RMS6);
#pragma unroll
        for (int j = 0; j < 16; ++j) { const int c = j * 256 + F.lane * 4; f32x4v v = *(const f32x4v*)(yr + c); const f32x4v gg = *(const f32x4v*)(g + c);
            v.x = v.x * rs * gg.x; v.y = v.y * rs * gg.y; v.z = v.z * rs * gg.z; v.w = v.w * rs * gg.w; *(f32x4v*)(yr + c) = v; }
    }
}

__global__ void __launch_bounds__(NWAVES * 64, 2) mk_fwd(Args args) {
    extern __shared__ __attribute__((aligned(16))) unsigned char lds[];
    Frame F;
    F.lds = (LAS unsigned char*)lds;
    volatile LAS unsigned* MISC = (volatile LAS unsigned*)(F.lds + MISC_OFF);
    F.tid = threadIdx.x; F.lane = F.tid & 63; F.wave = __builtin_amdgcn_readfirstlane(F.tid >> 6);
    F.G = gridDim.x; { const int bx = blockIdx.x; F.vcu = (F.G % 8 == 0) ? (bx % 8) * (F.G / 8) + bx / 8 : bx; }
    unsigned char* ws = args.ws;
    if (F.tid < 64) MISC[F.tid] = 0u;
    __syncthreads();
    XcdBarrier bar; bar.bar = (unsigned*)(ws + WS_CTL) + CW_BAR; bar.x = 0; bar.st = nullptr;
    if (MK_N_LAUNCHES == 1) bar = xcd_barrier_post((unsigned*)(ws + WS_CTL) + CW_BAR, MISC + 8);
    const int lo = args.ph_lo, hi = args.ph_hi;
#define IN(k) (lo <= (k) && (k) < hi)
#define SEAM(k) do { if (IN(k) && IN((k) + 1)) xcd_barrier(bar); } while (0)
    float* ssqb = (float*)(ws + WS_SSQ);
    bf16* xb = (bf16*)(ws + WS_XB); bf16* mixb = (bf16*)(ws + WS_MIX); bf16* big = (bf16*)(ws + WS_BIG); float* xres = (float*)(ws + WS_XRES);

    if (IN(0)) { p0_prologue(F, args); } SEAM(0);
    if (IN(1)) {
        pg8::Gemm g{xb, (const bf16*)(ws + WS_WINA), M, IN0, D}; pg8::StaticOrder S; S.init(M, IN0, F.G, (int)blockIdx.x);
        pg8::EpiRow<0> E{big, IN0, ssqb, nullptr, -1};
        pg8::gemm_phase<pg8::EpiRow<0>, pg8::StaticOrder, true, true>(F.lds, g, S, E);
    } SEAM(1);
    if (IN(2)) { attn_phase(F, args); } SEAM(2);
    if (IN(3)) {
        pg8::Gemm g{mixb, (const bf16*)(ws + WS_WOUTA), M, D, D}; pg8::StaticOrder S; S.init(M, D, F.G, (int)blockIdx.x);
        pg8::EpiRes E{args.in[I_XP], args.in[I_XS], xres, xb, ssqb + 1 * (size_t)M};
        pg8::gemm_phase<pg8::EpiRes, pg8::StaticOrder, true, true>(F.lds, g, S, E);
    } SEAM(3);
    if (IN(4)) {
        pg8::Gemm g{xb, (const bf16*)(ws + WS_WUP), M, DFF, D}; pg8::StaticOrder S; S.init(M, DFF, F.G, (int)blockIdx.x);
        pg8::EpiRow<1> E{big, DFF, ssqb + 1 * (size_t)M, nullptr, -1};
        pg8::gemm_phase<pg8::EpiRow<1>, pg8::StaticOrder, true, true>(F.lds, g, S, E);
    } SEAM(4);
    if (IN(5)) {
        pg8::Gemm g{big, (const bf16*)(ws + WS_WDN), M, D, DFF}; pg8::StaticOrder S; S.init(M, D, F.G, (int)blockIdx.x);
        pg8::EpiRes E{xres, xres + (size_t)NP * D, xres, xb, ssqb + 2 * (size_t)M};
        pg8::gemm_phase<pg8::EpiRes, pg8::StaticOrder, true, true>(F.lds, g, S, E);
    } SEAM(5);
    if (IN(6)) {
        pg8::Gemm g{xb, (const bf16*)(ws + WS_WING), M, IN1P, D}; pg8::StaticOrder S; S.init(M, IN1P, F.G, (int)blockIdx.x);
        pg8::EpiRow<0> E{big, IN1M, ssqb + 2 * (size_t)M, (float*)(ws + WS_AUX), 64};
        pg8::gemm_phase<pg8::EpiRow<0>, pg8::StaticOrder, true, true>(F.lds, g, S, E);
    } SEAM(6);
    if (IN(7)) { gdn_phase(F, args); } SEAM(7);
    if (IN(8)) {
        pg8::Gemm g{mixb, (const bf16*)(ws + WS_WOUTG), M, D, D}; pg8::StaticOrder S; S.init(M, D, F.G, (int)blockIdx.x);
        pg8::EpiRes E{xres, xres + (size_t)NP * D, xres, xb, ssqb + 3 * (size_t)M};
        pg8::gemm_phase<pg8::EpiRes, pg8::StaticOrder, true, true>(F.lds, g, S, E);
    } SEAM(8);
    if (IN(9)) {
        pg8::Gemm g{xb, (const bf16*)(ws + WS_WUP) + (size_t)DFF * D, M, DFF, D}; pg8::StaticOrder S; S.init(M, DFF, F.G, (int)blockIdx.x);
        pg8::EpiRow<1> E{big, DFF, ssqb + 3 * (size_t)M, nullptr, -1};
        pg8::gemm_phase<pg8::EpiRow<1>, pg8::StaticOrder, true, true>(F.lds, g, S, E);
    } SEAM(9);
    if (IN(10)) {
        pg8::Gemm g{big, (const bf16*)(ws + WS_WDN) + (size_t)D * DFF, M, D, DFF}; pg8::StaticOrder S; S.init(M, D, F.G, (int)blockIdx.x);
        pg8::EpiRes E{xres, xres + (size_t)NP * D, args.out + O_Y, nullptr, ssqb + 4 * (size_t)M};
        pg8::gemm_phase<pg8::EpiRes, pg8::StaticOrder, true, true>(F.lds, g, S, E);
    } SEAM(10);
    if (IN(11)) { final_phase(F, args); }
#undef IN
#undef SEAM
}

extern "C" void kernel_launch(void* const* d_in, const int* in_sizes, int n_in, void* d_out, int out_size, void* d_ws, size_t ws_size, hipStream_t stream) {
    static int grid = 0;
    if (grid == 0) {
        if (n_in != 23 || in_sizes[0] != NP * D || (size_t)out_size != O_END || ws_size < WS_END) {
            fprintf(stderr, "kernel_launch: unexpected shapes: n_in %d in0 %d out %d (want %zu) ws %zu (want %zu); nothing launched\n", n_in, n_in > 0 ? in_sizes[0] : -1, out_size, (size_t)O_END, ws_size, (size_t)WS_END); grid = -1; return; }
        int dev = 0, cus = 0, per_cu = 0;
        if (hipGetDevice(&dev) != hipSuccess || hipDeviceGetAttribute(&cus, hipDeviceAttributeMultiprocessorCount, dev) != hipSuccess) { fprintf(stderr, "kernel_launch: device query failed\n"); grid = -1; return; }
        if (hipFuncSetAttribute((const void*)mk_fwd, hipFuncAttributeMaxDynamicSharedMemorySize, LDS_BYTES) != hipSuccess) { fprintf(stderr, "kernel_launch: hipFuncSetAttribute failed\n"); grid = -1; return; }
        if (hipOccupancyMaxActiveBlocksPerMultiprocessor(&per_cu, (const void*)mk_fwd, NWAVES * 64, LDS_BYTES) != hipSuccess || per_cu < 1)
            fprintf(stderr, "kernel_launch: note: occupancy query reports %d workgroups per CU\n", per_cu);
        (void)hipGetLastError();
        grid = cus;
    }
    if (grid < 0) return;
    if (hipMemsetAsync((char*)d_ws + WS_CTL, 0, CTL_ZERO_BYTES, stream) != hipSuccess) { fprintf(stderr, "kernel_launch: memset failed\n"); return; }
    Args a{};
    for (int i = 0; i < 23; ++i) a.in[i] = (const float*)d_in[i];
    a.out = (float*)d_out; a.ws = (unsigned char*)d_ws;
    if (MK_N_LAUNCHES == 1) { a.ph_lo = 0; a.ph_hi = N_PHASES; hipLaunchKernelGGL(mk_fwd, dim3(grid), dim3(NWAVES * 64), LDS_BYTES, stream, a); }
    else { for (int p = 0; p < N_PHASES; ++p) { a.ph_lo = p; a.ph_hi = p + 1; hipLaunchKernelGGL(mk_fwd, dim3(grid), dim3(NWAVES * 64), LDS_BYTES, stream, a); } }
    const hipError_t le = hipPeekAtLastError();
    if (le != hipSuccess) fprintf(stderr, "kernel_launch: launch failed: %s\n", hipGetErrorName(le));
}
```

```cpp
#include <hip/hip_runtime.h>
#include <cstdio>
#include <cstdint>
namespace pg8 {
#define PG8_LAS __attribute__((address_space(3)))
typedef unsigned short bf16_t;
typedef short bf16x8 __attribute__((ext_vector_type(8)));
typedef float f32x4 __attribute__((ext_vector_type(4)));
typedef unsigned u32x4 __attribute__((ext_vector_type(4)));
constexpr int BM = 256, BK = 64, HALF = 128, HTB = HALF * BK * 2  , STAGE_BYTES = 8 * HTB, NXCD = 8, WGM = 8;

__host__ __device__ __forceinline__ int lds_byte(int r, int c) { const int st = (r >> 4) * 2 + (c >> 5), rr = r & 15, cc = c & 31, ob = rr * 64 + cc * 2; return st * 1024 + (ob ^ (((ob >> 9) & 1) << 5)); }
__host__ __device__ __forceinline__ void stage_rc(int b, int& R, int& C) { const int st = b / 1024, sb = b % 1024, swz = sb ^ (((sb >> 9) & 1) << 5); R = (st >> 1) * 16 + swz / 64; C = (st & 1) * 32 + (swz % 64) / 2; }
__host__ __device__ __forceinline__ int perm32(int rho) { const int n = rho >> 4, i = rho & 15; return 8 * (i >> 2) + 4 * n + (i & 3); }

struct Unit { int pm, pn, ks; };
struct Gemm { const bf16_t* A; const bf16_t* Bt; int M, N, K, ldk; };

struct StaticOrder {
    int nM, nN, nwg, G, c;
    __host__ __device__ void init(int M, int N, int G_, int c_) { nM = M / BM; nN = N / BM; nwg = nM * nN; G = G_; c = c_; }
    __host__ __device__ bool next(int i, Unit& u) const {
        const long L = (long)i * G + c; if (L >= nwg) return false;
        int wgid = (int)L; { const int q = nwg / NXCD, r = nwg % NXCD, xcd = wgid % NXCD, off = wgid / NXCD; wgid = (xcd < r ? xcd * (q + 1) : r * (q + 1) + (xcd - r) * q) + off; }
        const int nig = WGM * nN, gid = wgid / nig, fm = gid * WGM, gsz = (nM - fm) < WGM ? (nM - fm) : WGM;
        u.pm = fm + ((wgid % nig) % gsz); u.pn = (wgid % nig) / gsz; u.ks = 0; return true;
    }
    __device__ __forceinline__ void a_ready(const Unit&) const {}
    __device__ __forceinline__ void done(const Unit&) const {}
};


typedef float cvt_f32x2 __attribute__((ext_vector_type(2)));
typedef __bf16 cvt_bf16x2 __attribute__((ext_vector_type(2)));
__device__ __forceinline__ unsigned cvt_pk_bf16(float lo, float hi) { const cvt_f32x2 v = {lo, hi}; return __builtin_bit_cast(unsigned, __builtin_convertvector(v, cvt_bf16x2)); }
constexpr float RMS_EPS = 1e-6f;
constexpr int DMODEL = 4096;
template <int ACT> struct EpiRow {
    static constexpr bool PERM = true, AFTER_DRAIN = false;
    bf16_t* O; int ldc; const float* ssq; float* aux; int pn_aux;
    __device__ __forceinline__ void operator()(const f32x4 (&acc)[2][2][4][2], const Unit& u, int wr, int wc, int fr, int fq) const {
        const int row0 = u.pm * BM + wr * 64 + fr, ct = wc * 32 + 8 * fq;
        const bool isaux = (u.pn == pn_aux);
#pragma unroll
        for (int ai = 0; ai < 2; ++ai)
#pragma unroll
            for (int m = 0; m < 4; ++m) {
                const int row = row0 + ai * HALF + m * 16;
                const float rs = rsqrtf(ssq[row] * (1.0f / DMODEL) + RMS_EPS);
#pragma unroll
                for (int bj = 0; bj < 2; ++bj) {
                    f32x4 v0 = acc[ai][bj][m][0] * rs, v1 = acc[ai][bj][m][1] * rs;
                    if (ACT == 1) {
#pragma unroll
                        for (int j = 0; j < 4; ++j) { const float a = fmaxf(v0[j], 0.f), b = fmaxf(v1[j], 0.f); v0[j] = a * a; v1[j] = b * b; }
                    }
                    if (isaux) {
                        if (bj == 0 && ct < 64) { float* p = aux + (size_t)row * 64 + ct; *(f32x4*)p = v0; *(f32x4*)(p + 4) = v1; }
                    } else {
                        u32x4 w; w.x = cvt_pk_bf16(v0[0], v0[1]); w.y = cvt_pk_bf16(v0[2], v0[3]); w.z = cvt_pk_bf16(v1[0], v1[1]); w.w = cvt_pk_bf16(v1[2], v1[3]);
                        __builtin_nontemporal_store(w, (u32x4*)(O + (size_t)row * ldc + u.pn * BM + ct + bj * HALF));
                    }
                }
            }
    }
};
struct SplitOrder {
    int nN, nsplit, G, c;
    __device__ bool next(int i, Unit& u) const { const int L = i * G + c; if (L >= nN * nsplit) return false; u.pm = 0; u.pn = L / nsplit; u.ks = L % nsplit; return true; }
    __device__ __forceinline__ void a_ready(const Unit&) const {}
    __device__ __forceinline__ void done(const Unit&) const {}
};
struct EpiSlab {
    static constexpr bool PERM = false, AFTER_DRAIN = false;
    float* slab; int nsplit;
    __device__ __forceinline__ void operator()(const f32x4 (&acc)[2][2][4][2], const Unit& u, int wr, int wc, int fr, int fq) const {
        float* sb = slab + (size_t)(u.pn * nsplit + u.ks) * 65536 + (size_t)(wr * 64 + fr) * 256 + wc * 32 + 4 * fq;
#pragma unroll
        for (int ai = 0; ai < 2; ++ai)
#pragma unroll
            for (int m = 0; m < 4; ++m)
#pragma unroll
                for (int bj = 0; bj < 2; ++bj)
#pragma unroll
                    for (int n = 0; n < 2; ++n) *(f32x4*)(sb + (size_t)(ai * HALF + m * 16) * 256 + bj * HALF + n * 16) = acc[ai][bj][m][n];
    }
};
template <bool BASE_F32, bool OUT_F32> struct EpiRes {
    static constexpr bool PERM = true, AFTER_DRAIN = false;
    const void* base; void* out; float* ssq;
    __device__ __forceinline__ void operator()(const f32x4 (&acc)[2][2][4][2], const Unit& u, int wr, int wc, int fr, int fq) const {
        const int row0 = u.pm * BM + wr * 64 + fr, col0 = u.pn * BM + wc * 32 + 8 * fq;
#pragma unroll
        for (int ai = 0; ai < 2; ++ai)
#pragma unroll
            for (int m = 0; m < 4; ++m) {
                const int row = row0 + ai * HALF + m * 16; const size_t off = (size_t)row * DMODEL + col0;
                float s = 0.f;
#pragma unroll
                for (int bj = 0; bj < 2; ++bj) {
                    f32x4 b0, b1;
                    if (BASE_F32) { b0 = *(const f32x4*)((const float*)base + off + bj * HALF); b1 = *(const f32x4*)((const float*)base + off + bj * HALF + 4); }
                    else { const u32x4 w = *(const u32x4*)((const bf16_t*)base + off + bj * HALF);
                        b0[0] = __builtin_bit_cast(float, w.x << 16); b0[1] = __builtin_bit_cast(float, w.x & 0xffff0000u); b0[2] = __builtin_bit_cast(float, w.y << 16); b0[3] = __builtin_bit_cast(float, w.y & 0xffff0000u);
                        b1[0] = __builtin_bit_cast(float, w.z << 16); b1[1] = __builtin_bit_cast(float, w.z & 0xffff0000u); b1[2] = __builtin_bit_cast(float, w.w << 16); b1[3] = __builtin_bit_cast(float, w.w & 0xffff0000u); }
                    const f32x4 o0 = b0 + acc[ai][bj][m][0], o1 = b1 + acc[ai][bj][m][1];
                    s += ((o0[0] * o0[0] + o0[1] * o0[1]) + (o0[2] * o0[2] + o0[3] * o0[3])) + ((o1[0] * o1[0] + o1[1] * o1[1]) + (o1[2] * o1[2] + o1[3] * o1[3]));
                    if (OUT_F32) { *(f32x4*)((float*)out + off + bj * HALF) = o0; *(f32x4*)((float*)out + off + bj * HALF + 4) = o1; }
                    else { u32x4 w; w.x = cvt_pk_bf16(o0[0], o0[1]); w.y = cvt_pk_bf16(o0[2], o0[3]); w.z = cvt_pk_bf16(o1[0], o1[1]); w.w = cvt_pk_bf16(o1[2], o1[3]); *(u32x4*)((bf16_t*)out + off + bj * HALF) = w; }
                }
                s += __shfl_xor(s, 16); s += __shfl_xor(s, 32);
                if (fq == 0) ssq[(size_t)row * 64 + u.pn * 4 + wc] = s;
            }
    }
};
__device__ __forceinline__ __amdgpu_buffer_rsrc_t mk_rsrc(const void* p) {
    const unsigned lo = __builtin_amdgcn_readfirstlane((unsigned)(size_t)p), hi = __builtin_amdgcn_readfirstlane((unsigned)((size_t)p >> 32));
    return __builtin_amdgcn_make_buffer_rsrc((void*)(((size_t)hi << 32) | lo), 0, 0xFFFFF000u, 0x00020000);
}
template <class Epi, class Sched, bool ALIGN_EPI = false, bool SP2 = false>
__device__ __forceinline__ void gemm_phase(PG8_LAS unsigned char* lds, const Gemm g, const Sched& S, const Epi& E) {
    const int tid = threadIdx.x, wid = __builtin_amdgcn_readfirstlane(tid >> 6), lane = tid & 63, wr = wid >> 2, wc = wid & 3, fr = lane & 15, fq = lane >> 4;
    const int K = g.K, nt = K / BK;
    unsigned voffA[2], voffB[2];
#pragma unroll
    for (int i = 0; i < 2; ++i) { int R, C; stage_rc(tid * 16 + i * 8192, R, C); const int Rb = Epi::PERM ? ((R & ~31) + perm32(R & 31)) : R;
        voffA[i] = (unsigned)(R * g.ldk + C) * 2u; voffB[i] = (unsigned)(Rb * g.ldk + C) * 2u; }
    const unsigned kstep = (unsigned)(BK * 2);
    const unsigned hstep = (unsigned)(HALF * g.ldk * 2);
    const unsigned tstep = 2 * hstep;
    const unsigned ldsw = (unsigned)wid * 1024u;
    const int aoff = lds_byte(wr * 64 + fr, fq * 8), boff = lds_byte(wc * 32 + fr, fq * 8);
#define PG8_SA(b, h) (((b) * 2 + (h)) * HTB)
#define PG8_SB(b, h) ((4 + (b) * 2 + (h)) * HTB)
    const __amdgpu_buffer_rsrc_t rs_voffA = mk_rsrc(g.A), rs_voffB = mk_rsrc(g.Bt);
#define PG8_STAGE(bufoff, soff, voff) do { _Pragma("unroll") for (int _i = 0; _i < 2; ++_i) \
        __builtin_amdgcn_raw_ptr_buffer_load_lds(rs_##voff, (PG8_LAS void*)(lds + (bufoff) + ldsw + _i * 8192), 16, (voff)[_i], (soff), 0, 0); } while (0)
#define PG8_LDA(dst, b, h) do { _Pragma("unroll") for (int m = 0; m < 4; ++m) _Pragma("unroll") for (int k = 0; k < 2; ++k) dst[m][k] = *(const PG8_LAS bf16x8*)(lds + PG8_SA(b, h) + aoff + m * 2048 + k * 1024); } while (0)
#define PG8_LDB(dst, b, h) do { _Pragma("unroll") for (int n = 0; n < 2; ++n) _Pragma("unroll") for (int k = 0; k < 2; ++k) dst[n][k] = *(const PG8_LAS bf16x8*)(lds + PG8_SB(b, h) + boff + n * 2048 + k * 1024); } while (0)
#define PG8_MMA(ai, bj, At, Bt) do { __builtin_amdgcn_s_setprio(1); _Pragma("unroll") for (int m = 0; m < 4; ++m) _Pragma("unroll") for (int n = 0; n < 2; ++n) _Pragma("unroll") for (int k = 0; k < 2; ++k) \
        acc[ai][bj][m][n] = __builtin_amdgcn_mfma_f32_16x16x32_bf16(Bt[n][k], At[m][k], acc[ai][bj][m][n], 0, 0, 0); __builtin_amdgcn_s_setprio(0); } while (0)
#define PG8_WAIT_V(n) asm volatile("s_waitcnt vmcnt(" #n ")" ::: "memory")
#define PG8_WAIT_L(n) asm volatile("s_waitcnt lgkmcnt(" #n ")" ::: "memory")
#define PG8_BAR __builtin_amdgcn_s_barrier()
#define PG8_SCHED __builtin_amdgcn_sched_barrier(0)
    Unit cur, nxt; int ui = 0;
    if (!S.next(0, cur)) return;
    f32x4 acc[2][2][4][2];
#pragma unroll
    for (int a = 0; a < 2; ++a)
#pragma unroll
        for (int b = 0; b < 2; ++b)
#pragma unroll
            for (int m = 0; m < 4; ++m)
#pragma unroll
                for (int n = 0; n < 2; ++n) acc[a][b][m][n] = (f32x4){0.f, 0.f, 0.f, 0.f};
    bf16x8 At[4][2], B0[2][2], B1[2][2];
    unsigned cA = (unsigned)cur.pm * tstep + (unsigned)(cur.ks * K * 2), cB = (unsigned)cur.pn * tstep + (unsigned)(cur.ks * K * 2);
    S.a_ready(cur);
    if constexpr (SP2) {
        PG8_STAGE(PG8_SB(0, 0), cB, voffB); PG8_STAGE(PG8_SB(0, 1), cB + hstep, voffB); PG8_STAGE(PG8_SA(0, 0), cA, voffA); PG8_STAGE(PG8_SA(0, 1), cA + hstep, voffA);
        if (wr == 1) PG8_BAR;
        PG8_WAIT_V(2); PG8_BAR;
        PG8_STAGE(PG8_SB(1, 0), cB + kstep, voffB); PG8_STAGE(PG8_SA(1, 0), cA + kstep, voffA); PG8_STAGE(PG8_SB(1, 1), cB + hstep + kstep, voffB);
        PG8_WAIT_V(6); PG8_BAR;
    } else {
        PG8_STAGE(PG8_SB(0, 0), cB, voffB); PG8_STAGE(PG8_SA(0, 0), cA, voffA); PG8_STAGE(PG8_SB(0, 1), cB + hstep, voffB); PG8_STAGE(PG8_SA(0, 1), cA + hstep, voffA);
        if (wr == 1) PG8_BAR;
        PG8_WAIT_V(4); PG8_BAR;
        PG8_STAGE(PG8_SB(1, 0), cB + kstep, voffB); PG8_STAGE(PG8_SA(1, 0), cA + kstep, voffA); PG8_STAGE(PG8_SB(1, 1), cB + hstep + kstep, voffB);
        PG8_WAIT_V(6); PG8_BAR;
    }
    for (;;) {
        const bool has_next = S.next(ui + 1, nxt);
        const unsigned nA = has_next ? (unsigned)nxt.pm * tstep + (unsigned)(nxt.ks * K * 2) : cA, nB = has_next ? (unsigned)nxt.pn * tstep + (unsigned)(nxt.ks * K * 2) : cB;
        for (int t = 0; t < nt; t += 2) {
            const bool last = (t == nt - 2);
            const unsigned a1 = cA + (unsigned)(t + 1) * kstep;
            const unsigned a2 = last ? nA : cA + (unsigned)(t + 2) * kstep, b2 = last ? nB : cB + (unsigned)(t + 2) * kstep;
            const unsigned a3 = a2 + kstep, b3 = b2 + kstep;
            if (last && has_next) S.a_ready(nxt);
            if constexpr (SP2) {
            PG8_LDB(B0, 0, 0); PG8_LDB(B1, 0, 1); PG8_SCHED; PG8_LDA(At, 0, 0); PG8_STAGE(PG8_SA(1, 1), a1 + hstep, voffA);
            PG8_WAIT_V(8); PG8_WAIT_L(0); PG8_BAR; PG8_MMA(0, 0, At, B0); PG8_MMA(0, 1, At, B1); PG8_BAR; PG8_SCHED;
            PG8_LDA(At, 0, 1); PG8_STAGE(PG8_SB(0, 0), b2, voffB); PG8_STAGE(PG8_SB(0, 1), b2 + hstep, voffB); PG8_STAGE(PG8_SA(0, 0), a2, voffA);
            PG8_WAIT_V(8); PG8_WAIT_L(0); PG8_BAR; PG8_MMA(1, 0, At, B0); PG8_MMA(1, 1, At, B1); PG8_BAR; PG8_SCHED;
            PG8_LDB(B0, 1, 0); PG8_LDB(B1, 1, 1); PG8_SCHED; PG8_LDA(At, 1, 0); PG8_STAGE(PG8_SA(0, 1), a2 + hstep, voffA);
            PG8_WAIT_V(8); PG8_WAIT_L(0); PG8_BAR; PG8_MMA(0, 0, At, B0); PG8_MMA(0, 1, At, B1); PG8_BAR; PG8_SCHED;
            PG8_LDA(At, 1, 1); PG8_STAGE(PG8_SB(1, 0), b3, voffB); PG8_STAGE(PG8_SB(1, 1), b3 + hstep, voffB); PG8_STAGE(PG8_SA(1, 0), a3, voffA);
            PG8_WAIT_V(8); PG8_WAIT_L(0); PG8_BAR; PG8_MMA(1, 0, At, B0); PG8_MMA(1, 1, At, B1); PG8_BAR; PG8_SCHED;
            } else {
            PG8_LDB(B0, 0, 0); PG8_SCHED; PG8_LDA(At, 0, 0); PG8_STAGE(PG8_SA(1, 1), a1 + hstep, voffA);
            PG8_WAIT_L(8); PG8_BAR; PG8_WAIT_L(0); PG8_MMA(0, 0, At, B0); PG8_BAR; PG8_SCHED;
            PG8_LDB(B1, 0, 1); PG8_STAGE(PG8_SB(0, 0), b2, voffB);
            PG8_BAR; PG8_WAIT_L(0); PG8_MMA(0, 1, At, B1); PG8_BAR;
            PG8_LDA(At, 0, 1); PG8_STAGE(PG8_SA(0, 0), a2, voffA);
            PG8_BAR; PG8_WAIT_L(0); PG8_MMA(1, 0, At, B0); PG8_BAR; PG8_SCHED;
            PG8_STAGE(PG8_SB(0, 1), b2 + hstep, voffB);
            PG8_WAIT_V(6); PG8_BAR; PG8_MMA(1, 1, At, B1); PG8_BAR;
            PG8_LDB(B0, 1, 0); PG8_SCHED; PG8_LDA(At, 1, 0); PG8_STAGE(PG8_SA(0, 1), a2 + hstep, voffA);
            PG8_WAIT_L(8); PG8_BAR; PG8_WAIT_L(0); PG8_MMA(0, 0, At, B0); PG8_BAR; PG8_SCHED;
            PG8_LDB(B1, 1, 1); PG8_STAGE(PG8_SB(1, 0), b3, voffB);
            PG8_BAR; PG8_WAIT_L(0); PG8_MMA(0, 1, At, B1); PG8_BAR;
            PG8_LDA(At, 1, 1); PG8_STAGE(PG8_SA(1, 0), a3, voffA);
            PG8_BAR; PG8_WAIT_L(0); PG8_MMA(1, 0, At, B0); PG8_BAR; PG8_SCHED;
            PG8_STAGE(PG8_SB(1, 1), b3 + hstep, voffB);
            PG8_WAIT_V(6); PG8_BAR; PG8_MMA(1, 1, At, B1); PG8_BAR;
            }
        }
        if constexpr (ALIGN_EPI) { if (wr == 0) PG8_BAR; }
        if constexpr (!Epi::AFTER_DRAIN) { E(acc, cur, wr, wc, fr, fq); S.done(cur); }
        if (!has_next) break;
#pragma unroll
        for (int a = 0; a < 2; ++a)
#pragma unroll
            for (int b = 0; b < 2; ++b)
#pragma unroll
                for (int m = 0; m < 4; ++m)
#pragma unroll
                    for (int n = 0; n < 2; ++n) acc[a][b][m][n] = (f32x4){0.f, 0.f, 0.f, 0.f};
        cur = nxt; cA = nA; cB = nB; ++ui;
        if constexpr (ALIGN_EPI) { if (wr == 1) PG8_BAR; }
    }
    PG8_WAIT_V(0);
    if constexpr (!ALIGN_EPI) { if (wr == 0) PG8_BAR; }
    PG8_BAR;
    if constexpr (Epi::AFTER_DRAIN) { E.fused(acc, cur, wr, wc, fr, fq, lds, wid, lane); S.done(cur); }
#undef PG8_SA
#undef PG8_SB
#undef PG8_STAGE
#undef PG8_LDA
#undef PG8_LDB
#undef PG8_MMA
#undef PG8_WAIT_V
#undef PG8_WAIT_L
#undef PG8_BAR
#undef PG8_SCHED
}
}

#define GAS __attribute__((address_space(1)))
#define LAS __attribute__((address_space(3)))
typedef unsigned short bf16;
typedef unsigned v4u __attribute__((ext_vector_type(4)));
typedef float f32x4 __attribute__((ext_vector_type(4)));
typedef short bf16x8 __attribute__((ext_vector_type(8)));
typedef GAS unsigned gu32;
typedef GAS unsigned long long gu64;
#define RLX_AGENT __ATOMIC_RELAXED, __HIP_MEMORY_SCOPE_AGENT
#define LDS_WAIT() asm volatile("s_waitcnt lgkmcnt(0)" ::: "memory")
#define VM_WAIT() asm volatile("s_waitcnt vmcnt(0)" ::: "memory")
__device__ __forceinline__ unsigned long long rt() { return __builtin_amdgcn_s_memrealtime(); }
__device__ __forceinline__ unsigned f2bf(float f) { unsigned u = __builtin_bit_cast(unsigned, f); return (u + 0x7fffu + ((u >> 16) & 1u)) >> 16; }
__device__ __forceinline__ unsigned pk2(float lo, float hi) { return pg8::cvt_pk_bf16(lo, hi); }

#define XB_TMO      128
#define XB_XCNT(j)  (256  + 64 * (j))
#define XB_XSUB(j)  (1280 + 64 * (j))
#define XB_XGEN(j)  (2304 + 64 * (j))
#define XB_TOP      3328
#define XB_TOPGEN   3392
#define XCD_BAR_WORDS 3456
#define XB_SPIN_CAP (1u << 18)

__device__ __forceinline__ unsigned xb_ld(unsigned* p)              { return __hip_atomic_load(p, __ATOMIC_RELAXED, __HIP_MEMORY_SCOPE_AGENT); }
__device__ __forceinline__ unsigned xb_add(unsigned* p, unsigned v) { return __hip_atomic_fetch_add(p, v, __ATOMIC_RELAXED, __HIP_MEMORY_SCOPE_AGENT); }
__device__ __forceinline__ unsigned xb_xcc_id() { return (unsigned)__builtin_amdgcn_s_getreg((3 << 11) | 20) & 0xFu; }
#define XB_SPIN(cond, bar) do { unsigned _sp = 0; while (cond) { __builtin_amdgcn_s_sleep(1); \
    if ((++_sp & 255u) == 0u) { if (xb_ld(&(bar)[XB_TMO])) break; if (_sp > XB_SPIN_CAP) { atomicAdd(&(bar)[XB_TMO], 1u); break; } } } } while (0)

struct XcdBarrier {
    unsigned* bar; unsigned x;
    volatile LAS unsigned* st;
};

__device__ __forceinline__ XcdBarrier xcd_barrier_post(unsigned* bar, volatile LAS unsigned* st) {
    XcdBarrier b; b.bar = bar; b.x = xb_xcc_id(); b.st = st;
    if (threadIdx.x == 0) (void)xb_add(&bar[XB_XCNT(b.x)], 1u);
    return b;
}
__device__ __forceinline__ void xcd_barrier_complete(unsigned* bar, unsigned x, unsigned& nloc, unsigned& nx) {
    const unsigned G = gridDim.x * gridDim.y * gridDim.z;
    unsigned sum, cnt, mine, sp = 0u;
    for (;;) {
        sum = 0u; cnt = 0u; mine = 0u;
#pragma unroll
        for (unsigned j = 0; j < 16; ++j) { const unsigned c = xb_ld(&bar[XB_XCNT(j)]); sum += c; cnt += (c > 0u) ? 1u : 0u; mine = (j == x) ? c : mine; }
        if (sum == G) break;
        __builtin_amdgcn_s_sleep(1);
        if ((++sp & 255u) == 0u) { if (xb_ld(&bar[XB_TMO])) break; if (sp > XB_SPIN_CAP) { atomicAdd(&bar[XB_TMO], 1u); break; } }
    }
    nloc = mine > 0u ? mine : 1u; nx = cnt > 0u ? cnt : 1u;
}

__device__ __forceinline__ void xcd_barrier(const XcdBarrier& b) {
    asm volatile("s_waitcnt vmcnt(0)" ::: "memory");
    __syncthreads();
    if (threadIdx.x == 0) {
        unsigned* bar = b.bar;
        __builtin_amdgcn_s_waitcnt(0);
        unsigned nloc = b.st[0], nx = b.st[1];
        if (nloc == 0u) { xcd_barrier_complete(bar, b.x, nloc, nx); b.st[0] = nloc; b.st[1] = nx; }
        const unsigned old = xb_add(&bar[XB_XSUB(b.x)], 1u);
        const unsigned gen = old / nloc;
        if (old + 1u == (gen + 1u) * nloc) {
            __builtin_amdgcn_fence(__ATOMIC_RELEASE, "agent");
            asm volatile("s_waitcnt vmcnt(0)" ::: "memory");
            const unsigned og = xb_add(&bar[XB_TOP], 1u);
            const unsigned tg = og / nx;
            if (og + 1u == (tg + 1u) * nx) xb_add(&bar[XB_TOPGEN], 1u);
            else XB_SPIN(xb_ld(&bar[XB_TOPGEN]) == tg, bar);
            __builtin_amdgcn_fence(__ATOMIC_ACQUIRE, "agent");
            xb_add(&bar[XB_XGEN(b.x)], 1u);
            asm volatile("s_waitcnt vmcnt(0)" ::: "memory");
        } else {
            XB_SPIN(xb_ld(&bar[XB_XGEN(b.x)]) == gen, bar);
            __builtin_amdgcn_fence(__ATOMIC_ACQUIRE, "agent");
            asm volatile("s_waitcnt vmcnt(0)" ::: "memory");
        }
    }
    __syncthreads();
}

constexpr int NWAVES = 8;
#ifndef MK_N_LAUNCHES
#define MK_N_LAUNCHES 1
#endif
constexpr int N_PHASES = 12;
constexpr int D = 4096, SEQ = 2048, NB = 8, NSB = 16, NST = 16, PAST = 4096;
constexpr int NP = NB * SEQ;
constexpr int M = NP + NSB * NST;
constexpr int IN0 = 8704, IN1 = 16448, IN1M = 16384, IN1P = 16640, DFF = 16384;
constexpr int C_K = 2048, C_V = 2304, C_B = 2560, C_C = 4608, C_X = 6656;
constexpr int NH = 32, HD = 64, NKV = 4, GDH = 128, QKV = 12288;
constexpr size_t MiB = 1u << 20;
constexpr size_t WS_CTL = 0, CTL_ZERO_BYTES = 64 * 1024;
constexpr size_t WS_SSQ = 1 * MiB;
constexpr size_t WS_ROPE = 2 * MiB;
constexpr size_t WS_AUX = 3 * MiB;
constexpr size_t WS_WINA = 8 * MiB;
constexpr size_t WS_WOUTA = WS_WINA + 68 * MiB;
constexpr size_t WS_WING = WS_WOUTA + 32 * MiB;
constexpr size_t WS_WOUTG = WS_WING + 130 * MiB;
constexpr size_t WS_WUP = WS_WOUTG + 32 * MiB;
constexpr size_t WS_WDN = WS_WUP + 256 * MiB;
constexpr size_t WS_XB = WS_WDN + 256 * MiB;
constexpr size_t WS_MIX = WS_XB + 130 * MiB;
constexpr size_t WS_XRES = WS_MIX + 130 * MiB;
constexpr size_t WS_BIG = WS_XRES + 260 * MiB;
constexpr size_t WS_SLAB = WS_BIG + 520 * MiB;
constexpr size_t WS_SSQP = WS_SLAB + 64 * MiB;
constexpr size_t WS_END = WS_SSQP + 4 * MiB;
static_assert((size_t)M * D * 2 <= 130 * MiB && (size_t)M * D * 4 <= 260 * MiB && (size_t)M * DFF * 2 <= 520 * MiB && (size_t)IN1P * D * 2 <= 130 * MiB, "ws map");
constexpr int CW_CLAIM = 12032;
constexpr int CW_BAR = 4096;
constexpr int RING_BYTES = 131072;
constexpr int LDS_BYTES = 147456;
constexpr int MISC_OFF = LDS_BYTES - 256;
constexpr int SMALL_OFF = 133120;

typedef float f32x4v __attribute__((ext_vector_type(4)));
constexpr float RMS6 = 1e-6f;
__device__ __forceinline__ float bf2f(unsigned short b) { return __builtin_bit_cast(float, (unsigned)b << 16); }
__device__ __forceinline__ void unpack8(const v4u w, float* f) {
    f[0] = __builtin_bit_cast(float, w.x << 16); f[1] = __builtin_bit_cast(float, w.x & 0xffff0000u);
    f[2] = __builtin_bit_cast(float, w.y << 16); f[3] = __builtin_bit_cast(float, w.y & 0xffff0000u);
    f[4] = __builtin_bit_cast(float, w.z << 16); f[5] = __builtin_bit_cast(float, w.z & 0xffff0000u);
    f[6] = __builtin_bit_cast(float, w.w << 16); f[7] = __builtin_bit_cast(float, w.w & 0xffff0000u);
}
__device__ __forceinline__ v4u pack8(const float* f) { v4u o; o.x = pk2(f[0], f[1]); o.y = pk2(f[2], f[3]); o.z = pk2(f[4], f[5]); o.w = pk2(f[6], f[7]); return o; }
__device__ __forceinline__ float wave_sum(float v) {
#pragma unroll
    for (int o = 1; o < 64; o <<= 1) v += __shfl_xor(v, o);
    return v;
}
__device__ __forceinline__ float siluf(float x) { return x * __builtin_amdgcn_rcpf(1.0f + __expf(-x)); }

struct Args { const float* in[23]; float* out; unsigned char* ws; int ph_lo, ph_hi; };
enum { I_XP = 0, I_XS, I_CK, I_CV, I_SSC, I_SDC, I_SDN, I_ANORM, I_WINA, I_SINKS, I_SCW, I_WOUTA, I_DNORM, I_WING, I_DCW, I_ALOG, I_DTB, I_ONW, I_WOUTG, I_MNORM, I_WUP, I_WDN, I_FNORM };
constexpr size_t O_Y = 0;
constexpr size_t O_KP = (size_t)M * D;
constexpr size_t O_VP = O_KP + 8 * 128 * 256;
constexpr size_t O_KS = O_VP + 8 * 128 * 256;
constexpr size_t O_VS = O_KS + 16 * 128 * 256;
constexpr size_t O_CP = O_VS + 16 * 128 * 256;
constexpr size_t O_CS = O_CP + 8 * 2 * 2048;
constexpr size_t O_DCP = O_CS + 16 * 2 * 2048;
constexpr size_t O_DCS = O_DCP + 8 * 3 * 12288;
constexpr size_t O_DSP = O_DCS + 16 * 3 * 12288;
constexpr size_t O_DSS = O_DSP + (size_t)8 * 32 * 128 * 128;
constexpr size_t O_END = O_DSS + (size_t)16 * 32 * 128 * 128;

struct Frame {
    LAS unsigned char* lds; int tid, lane, wave, vcu, G;
};
constexpr int DEF_Q1 = 168, DEF_Q6 = 128, DEF_WG1 = 162, DEF_WG6 = 129, DEF_N1 = (256 - DEF_WG1) * DEF_Q1, DEF_N6 = (256 - DEF_WG6) * DEF_Q6;
static_assert(DEF_N1 <= 256 * 64 && DEF_N6 <= 64 * 256, "deferred items inside one layer's matrix");

__device__ __forceinline__ void p0_item(const float* W, int ldw, const float* gain, bf16* WT, int K, int k0, int n0, LAS float* scr, int lane) {
#pragma unroll 4
    for (int i = 0; i < 16; ++i) { const int kk = 4 * i + (lane >> 4);
        f32x4v v = *(const f32x4v*)(W + (size_t)(k0 + kk) * ldw + n0 + 4 * (lane & 15));
        const float g = gain ? gain[k0 + kk] : 1.0f; LAS float* s = scr + kk * 65 + 4 * (lane & 15);
        s[0] = v.x * g; s[1] = v.y * g; s[2] = v.z * g; s[3] = v.w * g; }
    LDS_WAIT(); asm volatile("" ::: "memory");
    const int c = lane & 7;
#pragma unroll
    for (int j = 0; j < 8; ++j) { const int n = (lane >> 3) + 8 * j; const LAS float* s = scr + (8 * c) * 65 + n;
        v4u o; o.x = pk2(s[0 * 65], s[1 * 65]); o.y = pk2(s[2 * 65], s[3 * 65]); o.z = pk2(s[4 * 65], s[5 * 65]); o.w = pk2(s[6 * 65], s[7 * 65]);
        *(GAS v4u*)(WT + (size_t)(n0 + n) * K + k0 + 8 * c) = o; }
    LDS_WAIT(); asm volatile("" ::: "memory");
}
constexpr int CW_S1 = 64, CW_S2 = CW_S1 + 256, CW_S3 = CW_S2 + 256, CW_S4 = CW_S3 + 257, CW_S5 = CW_S4 + 64, CW_S6 = CW_S5 + (16384 - DEF_N6) / 64, CW_END = CW_S6 + 256;
static_assert((16384 - DEF_N6) % 64 == 0, "the w_up[1] tail is whole chunks");
#ifndef CW_P0
#define CW_P0 0
#endif
__device__ __forceinline__ void conv_chunk(const Frame& F, const Args& a, int q) {
    LAS float* scr = (LAS float*)(F.lds + F.wave * 16640);
    const int lane = F.lane, c8 = lane & 7;
    const float* W; const float* gain = nullptr; bf16* WT; int ldw, K, ncol, r0;
    if (q < CW_S1)      { W = a.in[I_WOUTA]; WT = (bf16*)(a.ws + WS_WOUTA); ldw = D; K = D; ncol = 64; r0 = q * 64; }
    else if (q < CW_S2) { W = a.in[I_WUP]; gain = a.in[I_MNORM]; WT = (bf16*)(a.ws + WS_WUP); ldw = DFF; K = D; ncol = 256; r0 = (q - CW_S1) * 64; }
    else if (q < CW_S3) { W = a.in[I_WDN]; WT = (bf16*)(a.ws + WS_WDN); ldw = D; K = DFF; ncol = 64; r0 = (q - CW_S2) * 64; }
    else if (q < CW_S4) { W = a.in[I_WING]; gain = a.in[I_DNORM]; WT = (bf16*)(a.ws + WS_WING); ldw = IN1; K = D; ncol = 257; r0 = (q - CW_S3) * 64; }
    else if (q < CW_S5) { W = a.in[I_WOUTG]; WT = (bf16*)(a.ws + WS_WOUTG); ldw = D; K = D; ncol = 64; r0 = (q - CW_S4) * 64; }
    else if (q < CW_S6) { W = a.in[I_WUP] + (size_t)D * DFF; gain = a.in[I_MNORM] + D; WT = (bf16*)(a.ws + WS_WUP) + (size_t)DFF * D; ldw = DFF; K = D; ncol = 256; r0 = DEF_N6 + (q - CW_S5) * 64; }
    else                { W = a.in[I_WDN] + (size_t)DFF * D; WT = (bf16*)(a.ws + WS_WDN) + (size_t)D * DFF; ldw = D; K = DFF; ncol = 64; r0 = (q - CW_S6) * 64; }
    f32x4v buf[16];
    int r = r0 + F.wave; int k0 = 64 * (r / ncol), n0 = 64 * (r % ncol);
#pragma unroll
    for (int i = 0; i < 16; ++i) buf[i] = __builtin_nontemporal_load((const f32x4v*)(W + (size_t)(k0 + 4 * i + (lane >> 4)) * ldw + n0 + 4 * (lane & 15)));
    for (int it = 0; it < 8; ++it) {
#pragma unroll
        for (int i = 0; i < 16; ++i) { LAS float* s = scr + (4 * i + (lane >> 4)) * 65 + 4 * (lane & 15); s[0] = buf[i].x; s[1] = buf[i].y; s[2] = buf[i].z; s[3] = buf[i].w; }
        const int mk0 = k0, mn0 = n0;
        f32x4v g0 = (f32x4v){1.f, 1.f, 1.f, 1.f}, g1 = g0;
        if (gain) { g0 = *(const f32x4v*)(gain + mk0 + 8 * c8); g1 = *(const f32x4v*)(gain + mk0 + 8 * c8 + 4); }
        if (it + 1 < 8) { r += NWAVES; k0 = 64 * (r / ncol); n0 = 64 * (r % ncol);
#pragma unroll
            for (int i = 0; i < 16; ++i) buf[i] = __builtin_nontemporal_load((const f32x4v*)(W + (size_t)(k0 + 4 * i + (lane >> 4)) * ldw + n0 + 4 * (lane & 15))); }
        LDS_WAIT(); asm volatile("" ::: "memory");
#pragma unroll
        for (int jj = 0; jj < 8; ++jj) { const int n = (lane >> 3) + 8 * jj; const LAS float* s = scr + (8 * c8) * 65 + n;
            v4u o; o.x = pk2(s[0 * 65] * g0.x, s[1 * 65] * g0.y); o.y = pk2(s[2 * 65] * g0.z, s[3 * 65] * g0.w); o.z = pk2(s[4 * 65] * g1.x, s[5 * 65] * g1.y); o.w = pk2(s[6 * 65] * g1.z, s[7 * 65] * g1.w);
            __builtin_nontemporal_store(o, (GAS v4u*)(WT + (size_t)(mn0 + n) * K + mk0 + 8 * c8)); }
        LDS_WAIT(); asm volatile("" ::: "memory");
    }
}
__device__ __forceinline__ double rope_inv(int i) {
    return i == 0 ? 1.0 : i == 1 ? 0.19392274474868576 : i == 2 ? 0.03760603093086393 : i == 3 ? 0.007292664737217109 : i == 4 ? 0.001414213562373095 :
           i == 5 ? 0.0002742481756762073 : i == 6 ? 5.318295896944988e-05 : 1.031338537721246e-05;
}
__device__ __forceinline__ void p0_prologue(const Frame& F, const Args& a) {
    unsigned char* ws = a.ws;
    LAS float* scr = (LAS float*)(F.lds + F.wave * 16640);
    const int gw = F.vcu * NWAVES + F.wave, NGW = F.G * NWAVES;
    for (int r = gw; r < 64 * 136; r += NGW) p0_item(a.in[I_WINA], IN0, a.in[I_ANORM], (bf16*)(ws + WS_WINA), D, 64 * (r / 136), 64 * (r % 136), scr, F.lane);
    if (F.G != 256) for (int r = gw; r < DEF_N6; r += NGW) p0_item(a.in[I_WUP] + (size_t)D * DFF, DFF, a.in[I_MNORM] + D, (bf16*)(ws + WS_WUP) + (size_t)DFF * D, D, 64 * (r / 256), 64 * (r % 256), scr, F.lane);
    for (int q = F.vcu; q < CW_P0; q += F.G) conv_chunk(F, a, q);
    { GAS v4u* z = (GAS v4u*)((bf16*)(ws + WS_WING) + (size_t)IN1 * D); const int nz = (IN1P - IN1) * D / 8;
      for (int i = gw * 64 + F.lane; i < nz; i += NGW * 64) z[i] = (v4u){0u, 0u, 0u, 0u}; }
    float* ssq0 = (float*)(ws + WS_SSQ);
    for (int m = gw; m < M; m += NGW) {
        const float* xr = (m < NP) ? a.in[I_XP] + (size_t)m * D : a.in[I_XS] + (size_t)(m - NP) * D;
        bf16* ob = (bf16*)(ws + WS_XB) + (size_t)m * D;
        float s = 0.f;
#pragma unroll
        for (int j = 0; j < 8; ++j) {
            const f32x4v v0 = *(const f32x4v*)(xr + j * 512 + F.lane * 8), v1 = *(const f32x4v*)(xr + j * 512 + F.lane * 8 + 4);
            s += (v0.x * v0.x + v0.y * v0.y) + (v0.z * v0.z + v0.w * v0.w) + (v1.x * v1.x + v1.y * v1.y) + (v1.z * v1.z + v1.w * v1.w);
            v4u o; o.x = pk2(v0.x, v0.y); o.y = pk2(v0.z, v0.w); o.z = pk2(v1.x, v1.y); o.w = pk2(v1.z, v1.w);
            *(GAS v4u*)(ob + j * 512 + F.lane * 8) = o;
        }
        s = wave_sum(s);
        if (F.lane == 0) ssq0[m] = s;
    }
    float* rope = (float*)(ws + WS_ROPE);
    for (int i = (F.vcu * NWAVES * 64) + F.tid; i < 2064 * 8; i += F.G * NWAVES * 64) {
        const int pi = i >> 3, fi = i & 7; const int pos = pi < 2048 ? pi : PAST + (pi - 2048);
        const float angf = (float)pos * (float)rope_inv(fi);
        double rev = (double)angf * 0.15915494309189535; rev -= __builtin_rint(rev);
        const float r = (float)rev;
        rope[pi * 16 + fi] = __builtin_amdgcn_cosf(r); rope[pi * 16 + 8 + fi] = __builtin_amdgcn_sinf(r);
    }
}

__device__ __forceinline__ int pperm(int x) { return (x & ~31) | ((x & 12) << 1) | ((x & 16) >> 2) | (x & 3); }
__device__ __forceinline__ int cswz(int pcol, int m) { return (((pcol >> 3) ^ m) << 3) | (pcol & 7); }
typedef unsigned u32x2v __attribute__((ext_vector_type(2)));
__device__ __forceinline__ bf16x8 mk8(float a0, float a1, float a2, float a3, float a4, float a5, float a6, float a7) {
    v4u t; t.x = pg8::cvt_pk_bf16(a0, a1); t.y = pg8::cvt_pk_bf16(a2, a3); t.z = pg8::cvt_pk_bf16(a4, a5); t.w = pg8::cvt_pk_bf16(a6, a7); return __builtin_bit_cast(bf16x8, t); }
#define OPQ(v_) ({ int _t = (v_); asm volatile("" : "+v"(_t)); _t; })
__device__ __forceinline__ void p0_deferred(const Frame& F, const Args& a, int which, int j) {
    LAS float* scr = (LAS float*)(F.lds + F.wave * 16640);
    const int lane = F.lane, c8 = lane & 7;
    const float* W; const float* gain; bf16* WT; int ldw, K, ncol;
    if (which == 1) { W = a.in[I_WDN] + (size_t)DFF * D; gain = nullptr; WT = (bf16*)(a.ws + WS_WDN) + (size_t)D * DFF; ldw = D; K = DFF; ncol = 64; }
    else            { W = a.in[I_WUP] + (size_t)D * DFF; gain = a.in[I_MNORM] + D; WT = (bf16*)(a.ws + WS_WUP) + (size_t)DFF * D; ldw = DFF; K = D; ncol = 256; }
    f32x4v buf[16];
    const int DEF_Q = (which == 1) ? DEF_Q1 : DEF_Q6;
    int r = j * DEF_Q + F.wave; int k0 = 64 * (r / ncol), n0 = 64 * (r % ncol);
#pragma unroll
    for (int i = 0; i < 16; ++i) buf[i] = __builtin_nontemporal_load((const f32x4v*)(W + (size_t)(k0 + 4 * i + (lane >> 4)) * ldw + n0 + 4 * (lane & 15)));
    for (int q = F.wave; q < DEF_Q; q += NWAVES) {
#pragma unroll
        for (int i = 0; i < 16; ++i) { LAS float* s = scr + (4 * i + (lane >> 4)) * 65 + 4 * (lane & 15); s[0] = buf[i].x; s[1] = buf[i].y; s[2] = buf[i].z; s[3] = buf[i].w; }
        const int mk0 = k0, mn0 = n0;
        f32x4v g0 = (f32x4v){1.f, 1.f, 1.f, 1.f}, g1 = g0;
        if (gain) { g0 = *(const f32x4v*)(gain + mk0 + 8 * c8); g1 = *(const f32x4v*)(gain + mk0 + 8 * c8 + 4); }
        if (q + NWAVES < DEF_Q) { r += NWAVES; k0 = 64 * (r / ncol); n0 = 64 * (r % ncol);
#pragma unroll
            for (int i = 0; i < 16; ++i) buf[i] = __builtin_nontemporal_load((const f32x4v*)(W + (size_t)(k0 + 4 * i + (lane >> 4)) * ldw + n0 + 4 * (lane & 15))); }
        LDS_WAIT(); asm volatile("" ::: "memory");
#pragma unroll
        for (int jj = 0; jj < 8; ++jj) { const int n = (lane >> 3) + 8 * jj; const LAS float* s = scr + (8 * c8) * 65 + n;
            v4u o; o.x = pk2(s[0 * 65] * g0.x, s[1 * 65] * g0.y); o.y = pk2(s[2 * 65] * g0.z, s[3 * 65] * g0.w); o.z = pk2(s[4 * 65] * g1.x, s[5 * 65] * g1.y); o.w = pk2(s[6 * 65] * g1.z, s[7 * 65] * g1.w);
            __builtin_nontemporal_store(o, (GAS v4u*)(WT + (size_t)(mn0 + n) * K + mk0 + 8 * c8)); }
        LDS_WAIT(); asm volatile("" ::: "memory");
    }
}
__device__ __forceinline__ void rope8(float* mine, const float* other, const float* cs, bool second) {
#pragma unroll
    for (int i = 0; i < 8; ++i) mine[i] = second ? (mine[i] * cs[i] + other[i] * cs[8 + i]) : (mine[i] * cs[i] - other[i] * cs[8 + i]);
}
__device__ __forceinline__ void attn_phase(const Frame& F, const Args& a) {
    unsigned char* ws = a.ws;
    const bf16* proj = (const bf16*)(ws + WS_BIG); bf16* mix = (bf16*)(ws + WS_MIX);
    const float* rope = (const float*)(ws + WS_ROPE);
    constexpr int AK_STR = 72, AV_STR = 200;
    LAS bf16* kN = (LAS bf16*)F.lds; LAS bf16* vT = kN + 192 * AK_STR;
    const int tid = F.tid, lane = F.lane, w = F.wave;
    constexpr int NU = 1024 + 64;
#define AMFMA(A_, B_, C_) __builtin_amdgcn_mfma_f32_16x16x32_bf16((A_), (B_), (C_), 0, 0, 0)
    for (int u = F.vcu; u < NU; u += F.G) {
        const bool samp = u >= 1024;
        int n, c, kvh, kb0, nvalid;
        if (!samp) { n = u >> 7; c = (u >> 2) & 31; kvh = u & 3; kb0 = c >= 2 ? 0 : (2 - c); nvalid = 192; }
        else { const int v = u - 1024; n = v >> 2; c = 0; kvh = v & 3; kb0 = 0; nvalid = 144; }
        const int head = kvh * 8 + w;
        v4u kraw[3], vraw[3], qraw[2][2][2];
        { const int td = OPQ(tid);
#pragma unroll
          for (int it = 0; it < 3; ++it) { const int slot = it * 512 + td, j = slot >> 3, ch = slot & 7, pos = (c - 2) * 64 + j;
              kraw[it] = (v4u){0u, 0u, 0u, 0u}; vraw[it] = kraw[it];
              if (!samp && pos >= 0) { const bf16* r = proj + ((size_t)n * SEQ + pos) * IN0 + kvh * 64 + ch * 8; kraw[it] = *(const GAS v4u*)(r + C_K); vraw[it] = *(const GAS v4u*)(r + C_V); } }
          const int ln = OPQ(lane), r16 = ln & 15, g4 = ln >> 4;
#pragma unroll
          for (int qh = 0; qh < 2; ++qh)
#pragma unroll
              for (int qt = 0; qt < 2; ++qt) { const int ql = qh * 32 + qt * 16 + r16;
                  const size_t qr = samp ? (size_t)NP + n * NST + r16 : (size_t)n * SEQ + c * 64 + ql;
                  const bf16* qp = proj + qr * IN0 + head * 64 + 8 * g4; qraw[qh][qt][0] = *(const GAS v4u*)qp; qraw[qh][qt][1] = *(const GAS v4u*)(qp + 32); } }
        __syncthreads();
#pragma unroll
        for (int it = 0; it < 3; ++it) {
            const int slot = it * 512 + OPQ(tid), j = slot >> 3, ch = slot & 7;
            float kf[8], vf[8]; bool rot = false; int pi = 0;
#pragma unroll
            for (int i = 0; i < 8; ++i) { kf[i] = 0.f; vf[i] = 0.f; }
            if (!samp) {
                const int pos = (c - 2) * 64 + j;
                if (pos >= 0) { unpack8(kraw[it], kf); unpack8(vraw[it], vf); rot = true; pi = pos; }
            } else {
                if (j < 128) { const size_t o = (((size_t)n * 128 + j) * 4 + kvh) * 64 + ch * 8;
                    const f32x4v k0 = *(const f32x4v*)(a.in[I_CK] + o), k1 = *(const f32x4v*)(a.in[I_CK] + o + 4), v0 = *(const f32x4v*)(a.in[I_CV] + o), v1 = *(const f32x4v*)(a.in[I_CV] + o + 4);
                    kf[0] = k0.x; kf[1] = k0.y; kf[2] = k0.z; kf[3] = k0.w; kf[4] = k1.x; kf[5] = k1.y; kf[6] = k1.z; kf[7] = k1.w;
                    vf[0] = v0.x; vf[1] = v0.y; vf[2] = v0.z; vf[3] = v0.w; vf[4] = v1.x; vf[5] = v1.y; vf[6] = v1.z; vf[7] = v1.w; }
                else if (j < 144) { const bf16* r = proj + ((size_t)NP + n * NST + (j - 128)) * IN0 + kvh * 64 + ch * 8;
                    unpack8(*(const GAS v4u*)(r + C_K), kf); unpack8(*(const GAS v4u*)(r + C_V), vf); rot = true; pi = 2048 + (j - 128); }
            }
            float ot[8];
#pragma unroll
            for (int i = 0; i < 8; ++i) ot[i] = __shfl_xor(kf[i], 1);
            if (rot && ch < 2) { float cs[16];
#pragma unroll
                for (int i = 0; i < 4; ++i) { const f32x4v t = *(const f32x4v*)(rope + pi * 16 + 4 * i); cs[4 * i] = t.x; cs[4 * i + 1] = t.y; cs[4 * i + 2] = t.z; cs[4 * i + 3] = t.w; }
                rope8(kf, ot, cs, ch == 1); }
            { v4u kw; kw.x = pg8::cvt_pk_bf16(kf[0], kf[1]); kw.y = pg8::cvt_pk_bf16(kf[2], kf[3]); kw.z = pg8::cvt_pk_bf16(kf[4], kf[5]); kw.w = pg8::cvt_pk_bf16(kf[6], kf[7]);
              *(LAS v4u*)(kN + j * AK_STR + ch * 8) = kw;
              LAS bf16* vd = vT + (ch * 8) * AV_STR + cswz(pperm(j), ch >> 1);
#pragma unroll
              for (int i = 0; i < 8; ++i) vd[i * AV_STR] = (bf16)(pg8::cvt_pk_bf16(vf[i], 0.f) & 0xffffu); }
            int p = -1; float* ko = nullptr; float* vo = nullptr;
            if (!samp) { if (c == 31 && j >= 64) { p = j - 64; ko = a.out + O_KP; vo = a.out + O_VP; } }
            else { if (j >= 16 && j < 144) { p = j - 16; ko = a.out + O_KS; vo = a.out + O_VS; } }
            if (p >= 0) { const size_t o = (((size_t)n * 128 + p) * 4 + kvh) * 64 + ch * 8;
                *(f32x4v*)(ko + o) = (f32x4v){kf[0], kf[1], kf[2], kf[3]}; *(f32x4v*)(ko + o + 4) = (f32x4v){kf[4], kf[5], kf[6], kf[7]};
                *(f32x4v*)(vo + o) = (f32x4v){vf[0], vf[1], vf[2], vf[3]}; *(f32x4v*)(vo + o + 4) = (f32x4v){vf[4], vf[5], vf[6], vf[7]}; }
        }
        __syncthreads();
        const float sinkv = a.in[I_SINKS][head];
#pragma unroll
        for (int qh = 0; qh < 2; ++qh) { if (samp && qh == 1) break;
            const int ln = OPQ(lane), r16 = ln & 15, g4 = ln >> 4;
            bf16x8 qf[2][2];
#pragma unroll
            for (int qt = 0; qt < 2; ++qt) {
                const int ql = qh * 32 + qt * 16 + r16;
                const int qpi = samp ? 2048 + r16 : c * 64 + ql;
                const v4u w0 = qraw[qh][qt][0], w1 = qraw[qh][qt][1];
                float x[8], y[8], ot[8]; unpack8(w0, x); unpack8(w1, y);
                v4u wo; wo.x = __shfl_xor(w0.x, 16); wo.y = __shfl_xor(w0.y, 16); wo.z = __shfl_xor(w0.z, 16); wo.w = __shfl_xor(w0.w, 16); unpack8(wo, ot);
                if (g4 < 2) { float cs[16];
#pragma unroll
                    for (int i = 0; i < 4; ++i) { const f32x4v t = *(const f32x4v*)(rope + qpi * 16 + 4 * i); cs[4 * i] = t.x; cs[4 * i + 1] = t.y; cs[4 * i + 2] = t.z; cs[4 * i + 3] = t.w; }
                    rope8(x, ot, cs, g4 == 1); }
                qf[qt][0] = mk8(x[0] * 0.125f, x[1] * 0.125f, x[2] * 0.125f, x[3] * 0.125f, x[4] * 0.125f, x[5] * 0.125f, x[6] * 0.125f, x[7] * 0.125f);
                qf[qt][1] = mk8(y[0] * 0.125f, y[1] * 0.125f, y[2] * 0.125f, y[3] * 0.125f, y[4] * 0.125f, y[5] * 0.125f, y[6] * 0.125f, y[7] * 0.125f);
            }
            float mx[2] = {sinkv, sinkv}, ls[2]; ls[0] = (g4 == 0) ? 1.0f : 0.0f; ls[1] = ls[0];
            f32x4 O[4][2];
#pragma unroll
            for (int dt = 0; dt < 4; ++dt)
#pragma unroll
                for (int qt = 0; qt < 2; ++qt) O[dt][qt] = (f32x4){0.f, 0.f, 0.f, 0.f};
#pragma unroll 1
            for (int kb = kb0; kb < 3; ++kb) {
                f32x4 S[4][2];
#pragma unroll
                for (int kt = 0; kt < 4; ++kt)
#pragma unroll
                    for (int qt = 0; qt < 2; ++qt) S[kt][qt] = (f32x4){0.f, 0.f, 0.f, 0.f};
                { bf16x8 ak[2][4];
#pragma unroll
                  for (int ks = 0; ks < 2; ++ks)
#pragma unroll
                      for (int kt = 0; kt < 4; ++kt) ak[ks][kt] = *(const LAS bf16x8*)(kN + (64 * kb + 16 * kt + r16) * AK_STR + 32 * ks + 8 * g4);
#pragma unroll
                  for (int ks = 0; ks < 2; ++ks)
#pragma unroll
                      for (int kt = 0; kt < 4; ++kt)
#pragma unroll
                          for (int qt = 0; qt < 2; ++qt) S[kt][qt] = AMFMA(ak[ks][kt], qf[qt][ks], S[kt][qt]); }
                bf16x8 av[2][4];
#pragma unroll
                for (int ksk = 0; ksk < 2; ++ksk)
#pragma unroll
                    for (int dt = 0; dt < 4; ++dt) av[ksk][dt] = *(const LAS bf16x8*)(vT + (16 * dt + r16) * AV_STR + (((8 * kb + 4 * ksk + g4) ^ dt) << 3));
                if (64 * kb + 64 > nvalid) {
#pragma unroll
                    for (int kt = 0; kt < 4; ++kt)
#pragma unroll
                        for (int rr = 0; rr < 4; ++rr) if (64 * kb + 16 * kt + 4 * g4 + rr >= nvalid) { S[kt][0][rr] = -1e30f; S[kt][1][rr] = -1e30f; } }
                bf16x8 pb[2][2];
#pragma unroll
                for (int qt = 0; qt < 2; ++qt) {
                    float bm = -1e30f;
#pragma unroll
                    for (int kt = 0; kt < 4; ++kt) bm = fmaxf(fmaxf(bm, fmaxf(S[kt][qt][0], S[kt][qt][1])), fmaxf(S[kt][qt][2], S[kt][qt][3]));
                    bm = fmaxf(bm, __shfl_xor(bm, 16)); bm = fmaxf(bm, __shfl_xor(bm, 32));
                    const float mn = fmaxf(mx[qt], bm), corr = __expf(mx[qt] - mn); mx[qt] = mn;
                    float lsum = 0.f;
#pragma unroll
                    for (int kt = 0; kt < 4; ++kt)
#pragma unroll
                        for (int rr = 0; rr < 4; ++rr) { const float p = __expf(S[kt][qt][rr] - mn); S[kt][qt][rr] = p; lsum += p; }
                    ls[qt] = ls[qt] * corr + lsum;
#pragma unroll
                    for (int dt = 0; dt < 4; ++dt) O[dt][qt] = O[dt][qt] * corr;
                    pb[qt][0] = mk8(S[0][qt][0], S[0][qt][1], S[0][qt][2], S[0][qt][3], S[1][qt][0], S[1][qt][1], S[1][qt][2], S[1][qt][3]);
                    pb[qt][1] = mk8(S[2][qt][0], S[2][qt][1], S[2][qt][2], S[2][qt][3], S[3][qt][0], S[3][qt][1], S[3][qt][2], S[3][qt][3]);
                }
#pragma unroll
                for (int ksk = 0; ksk < 2; ++ksk)
#pragma unroll
                    for (int dt = 0; dt < 4; ++dt)
#pragma unroll
                        for (int qt = 0; qt < 2; ++qt) O[dt][qt] = AMFMA(av[ksk][dt], pb[qt][ksk], O[dt][qt]);
            }
#pragma unroll
            for (int qt = 0; qt < 2; ++qt) {
                float lt = ls[qt]; lt += __shfl_xor(lt, 16); lt += __shfl_xor(lt, 32);
                const float il = 1.0f / lt;
                const int ql = qh * 32 + qt * 16 + r16;
                const bool act = samp ? (qt == 0) : true;
                const size_t qr = samp ? (size_t)NP + n * NST + r16 : (size_t)n * SEQ + c * 64 + ql;
                if (act) {
#pragma unroll
                    for (int dt = 0; dt < 4; ++dt) { u32x2v o; o.x = pg8::cvt_pk_bf16(O[dt][qt][0] * il, O[dt][qt][1] * il); o.y = pg8::cvt_pk_bf16(O[dt][qt][2] * il, O[dt][qt][3] * il);
                        *(GAS u32x2v*)(mix + qr * D + head * 64 + 16 * dt + 4 * g4) = o; } }
            }
        }
    }
#undef AMFMA
    {
        const float* cw = a.in[I_SCW];
        const int cg = tid & 255, hf = tid >> 8, ch0 = cg * 8;
        float w0[8], w1[8], w2[8];
#pragma unroll
        for (int i = 0; i < 8; ++i) { w0[i] = cw[ch0 + i]; w1[i] = cw[2048 + ch0 + i]; w2[i] = cw[4096 + ch0 + i]; }
        for (int u = F.vcu; u < 512 + 16; u += F.G) {
            int T, ta, tb; size_t rowb; const float* st = nullptr; float* so;
            if (u < 512) { const int n = u >> 6, seg = u & 63; T = SEQ; rowb = (size_t)n * SEQ; ta = seg * 32 + hf * 16; tb = ta + 16; so = a.out + O_CP + (size_t)n * 2 * 2048; }
            else { const int n = u - 512; T = NST; rowb = (size_t)NP + n * NST; ta = hf * 8; tb = ta + 8; st = a.in[I_SSC] + (size_t)n * 2 * 2048; so = a.out + O_CS + (size_t)n * 2 * 2048; }
            float um2[8], um1[8];
#pragma unroll
            for (int i = 0; i < 8; ++i) { um2[i] = 0.f; um1[i] = 0.f; }
            for (int t = ta - 2; t < tb; ++t) {
                float uc[8], bg[8];
                if (t >= 0) { const bf16* r = proj + (rowb + t) * IN0 + ch0; float cgv[8], xv[8];
                    unpack8(*(const GAS v4u*)(r + C_C), cgv); unpack8(*(const GAS v4u*)(r + C_X), xv); unpack8(*(const GAS v4u*)(r + C_B), bg);
#pragma unroll
                    for (int i = 0; i < 8; ++i) uc[i] = cgv[i] * xv[i]; }
                else {
#pragma unroll
                    for (int i = 0; i < 8; ++i) { uc[i] = st ? st[(size_t)(2 + t) * 2048 + ch0 + i] : 0.f; bg[i] = 0.f; } }
                if (t >= ta) { float z[8];
#pragma unroll
                    for (int i = 0; i < 8; ++i) z[i] = bg[i] * (w0[i] * um2[i] + w1[i] * um1[i] + w2[i] * uc[i]);
                    *(GAS v4u*)(mix + (rowb + t) * D + 2048 + ch0) = pack8(z); }
                if (t >= T - 2 && t >= ta) { float* o = so + (size_t)(t - (T - 2)) * 2048 + ch0;
                    *(f32x4v*)o = (f32x4v){uc[0], uc[1], uc[2], uc[3]}; *(f32x4v*)(o + 4) = (f32x4v){uc[4], uc[5], uc[6], uc[7]}; }
#pragma unroll
                for (int i = 0; i < 8; ++i) { um2[i] = um1[i]; um1[i] = uc[i]; }
            }
        }
    }
}

constexpr int GQ_STR = 136, GT_STR = 72;
constexpr int G_QP = 0, G_KP = 17408, G_KT = 34816, G_VT = 53248, G_WP = 71680, G_AQ = 89088, G_TU = 98304, G_TW = 107520, G_AF = 116736, G_ST = 71680, G_SM = 137216;
constexpr int G_CW = 139264;
constexpr int G_OS = G_TU;
constexpr int AF_STR = 68;
#define GMFMA(A_, B_, C_) __builtin_amdgcn_mfma_f32_16x16x32_bf16((A_), (B_), (C_), 0, 0, 0)
#define LBAR() do { asm volatile("s_waitcnt lgkmcnt(0)" ::: "memory"); __builtin_amdgcn_s_barrier(); asm volatile("" ::: "memory"); } while (0)
__device__ __forceinline__ void gdn_phase(const Frame& F, const Args& a) {
    unsigned char* ws = a.ws;
    const bf16* proj = (const bf16*)(ws + WS_BIG); const float* aux = (const float*)(ws + WS_AUX); bf16* og = (bf16*)(ws + WS_MIX);
    LAS unsigned char* L = F.lds;
    LAS bf16* qP = (LAS bf16*)(L + G_QP); LAS bf16* kP = (LAS bf16*)(L + G_KP); LAS bf16* kT = (LAS bf16*)(L + G_KT); LAS bf16* vT = (LAS bf16*)(L + G_VT);
    LAS bf16* wP = (LAS bf16*)(L + G_WP); LAS bf16* aqP = (LAS bf16*)(L + G_AQ); LAS bf16* TuP = (LAS bf16*)(L + G_TU); LAS bf16* TwP = (LAS bf16*)(L + G_TW);
    LAS float* Af = (LAS float*)(L + G_AF); LAS float* os = (LAS float*)(L + G_OS); LAS float* stash = (LAS float*)(L + G_ST); LAS float* Xf = (LAS float*)(L + G_WP);
    LAS float* cwl = (LAS float*)(L + G_CW);
    LAS float* sm = (LAS float*)(L + G_SM); LAS float* ssq = sm; LAS float* Gs = sm + 128; LAS float* eGs = sm + 192; LAS float* eGls = sm + 256; LAS float* bes = sm + 320; LAS float* rqs = sm + 384; LAS float* rks = sm + 448;
    const int tid = F.tid, lane = F.lane, w = F.wave;
    const float* cw = a.in[I_DCW];
    for (int ch = F.vcu; ch < 256 + 512; ch += F.G) {
        const bool samp = ch >= 256;
        int n, h, T, TB; size_t rowb;
        if (!samp) { n = ch >> 5; h = ch & 31; T = SEQ; TB = 64; rowb = (size_t)n * SEQ; }
        else { const int v = ch - 256; n = v >> 5; h = v & 31; T = NST; TB = 16; rowb = (size_t)NP + n * NST; }
        const float Aexp = __expf(a.in[I_ALOG][h]), dtb = a.in[I_DTB][h];
        f32x4 S[8];
        { const int ln = OPQ(lane), r16 = ln & 15, g4 = ln >> 4;
        if (samp) { const float* s0 = a.in[I_SDN] + (((size_t)n * 32 + h) * 128) * 128;
#pragma unroll
            for (int dt = 0; dt < 8; ++dt)
#pragma unroll
                for (int rg_ = 0; rg_ < 4; ++rg_) S[dt][rg_] = s0[(size_t)(16 * dt + 4 * g4 + rg_) * 128 + 16 * w + r16]; }
        else {
#pragma unroll
            for (int dt = 0; dt < 8; ++dt) S[dt] = (f32x4){0.f, 0.f, 0.f, 0.f}; } }
        LBAR();
        if (tid < 384) {
#pragma unroll
            for (int i = 0; i < 4; ++i) cwl[i * 384 + tid] = cw[(size_t)i * QKV + (tid >> 7) * 4096 + h * 128 + (tid & 127)]; }
        if (tid < 128) ssq[tid] = 0.f;
        v4u P[10]; float av = 0.f, bv = 0.f;
#define GDN_PREFETCH(tn_) do { const int td_ = OPQ(tid), cg_ = td_ % 48, rg_ = td_ / 48, gch_ = (cg_ >> 4) * 4096 + h * 128 + (cg_ & 15) * 8; const int tn = (tn_); \
            if (rg_ < 10) { _Pragma("unroll") for (int r = 0; r < 10; ++r) { const int t = tn + rg_ * 7 + r - 3; \
                if (t >= 0 && t < T) P[r] = *(const GAS v4u*)(proj + (rowb + t) * IN1M + gch_); \
                else if (t < 0 && samp) { const float* sp = a.in[I_SDC] + ((size_t)n * 3 + (3 + t)) * QKV + gch_; P[r] = pack8(sp); } \
                else P[r] = (v4u){0u, 0u, 0u, 0u}; } } \
            if (w == 7) { const int ln_ = OPQ(lane); av = 0.f; bv = 0.f; if (ln_ < TB && tn + ln_ < T) { av = aux[(rowb + tn + ln_) * 64 + h]; bv = aux[(rowb + tn + ln_) * 64 + 32 + h]; } } } while (0)
        GDN_PREFETCH(0);
        for (int t0 = 0; t0 < T; t0 += 64) {
            LBAR();
            v4u gt0 = (v4u){0u, 0u, 0u, 0u}, gt1 = gt0;
            { const int td = OPQ(tid), r = td >> 3, j = td & 7;
              if (r < TB) { const bf16* gp = proj + (rowb + t0 + r) * IN1M + QKV + h * 128 + j * 16; gt0 = *(const GAS v4u*)gp; gt1 = *(const GAS v4u*)(gp + 8); } }
            { const int td = OPQ(tid), cg = td % 48, rg = td / 48, part = cg >> 4, c0 = (cg & 15) * 8, gch = part * 4096 + h * 128 + c0;
            if (rg < 10) {
                float cwv[4][8];
#pragma unroll
                for (int i = 0; i < 4; ++i) { const f32x4v c0v = *(const LAS f32x4v*)(cwl + i * 384 + part * 128 + c0), c1v = *(const LAS f32x4v*)(cwl + i * 384 + part * 128 + c0 + 4);
                    cwv[i][0] = c0v.x; cwv[i][1] = c0v.y; cwv[i][2] = c0v.z; cwv[i][3] = c0v.w; cwv[i][4] = c1v.x; cwv[i][5] = c1v.y; cwv[i][6] = c1v.z; cwv[i][7] = c1v.w; }
                float w0[8], w1[8], w2[8]; unpack8(P[0], w0); unpack8(P[1], w1); unpack8(P[2], w2);
#pragma unroll
                for (int r = 3; r < 10; ++r) { const int t = t0 + rg * 7 + r - 3, lr = rg * 7 + r - 3;
                    float cur[8]; unpack8(P[r], cur);
                    if (t >= T - 3 && t < T) { float* o = a.out + (samp ? O_DCS : O_DCP) + ((size_t)n * 3 + (t - (T - 3))) * QKV + gch;
                        *(f32x4v*)o = (f32x4v){cur[0], cur[1], cur[2], cur[3]}; *(f32x4v*)(o + 4) = (f32x4v){cur[4], cur[5], cur[6], cur[7]}; }
                    float ss = 0.f; const float lf = (lr < TB) ? 1.0f : 0.0f; float yv[8];
#pragma unroll
                    for (int k = 0; k < 8; ++k) { const float x = __builtin_fmaf(cwv[3][k], cur[k], __builtin_fmaf(cwv[2][k], w2[k], __builtin_fmaf(cwv[1][k], w1[k], cwv[0][k] * w0[k])));
                        const float yy = x * __builtin_amdgcn_rcpf(1.0f + __expf(-x)) * lf; yv[k] = yy; ss = __builtin_fmaf(yy, yy, ss); }
                    float ssr = ss; ssr += __shfl_xor(ssr, 1); ssr += __shfl_xor(ssr, 2); ssr += __shfl_xor(ssr, 4); ssr += __shfl_xor(ssr, 8);
                    if (lr < 64) {
                        u32x2v lo, hi; lo.x = pg8::cvt_pk_bf16(yv[0], yv[1]); lo.y = pg8::cvt_pk_bf16(yv[2], yv[3]); hi.x = pg8::cvt_pk_bf16(yv[4], yv[5]); hi.y = pg8::cvt_pk_bf16(yv[6], yv[7]);
                        if (part < 2) { LAS bf16* d = (part == 0 ? qP : kP) + lr * GQ_STR + pperm(c0); *(LAS u32x2v*)d = lo; *(LAS u32x2v*)(d + 8) = hi;
                            if ((cg & 15) == 0) ssq[lr * 2 + part] = ssr; }
                        if (part >= 1) { LAS bf16* d = (part == 1 ? kT : vT) + c0 * GT_STR + cswz(pperm(lr), c0 >> 4);
                            d[0 * GT_STR] = (bf16)(lo.x & 0xffffu); d[1 * GT_STR] = (bf16)(lo.x >> 16); d[2 * GT_STR] = (bf16)(lo.y & 0xffffu); d[3 * GT_STR] = (bf16)(lo.y >> 16);
                            d[4 * GT_STR] = (bf16)(hi.x & 0xffffu); d[5 * GT_STR] = (bf16)(hi.x >> 16); d[6 * GT_STR] = (bf16)(hi.y & 0xffffu); d[7 * GT_STR] = (bf16)(hi.y >> 16); }
                    }
#pragma unroll
                    for (int k = 0; k < 8; ++k) { w0[k] = w1[k]; w1[k] = w2[k]; w2[k] = cur[k]; }
                    __builtin_amdgcn_sched_barrier(0);
                }
            } }
            if (w == 7) { float gv = 0.f, be = 0.f;
                if (lane < TB) { const float x = av + dtb; const float sp = fmaxf(x, 0.f) + log1pf(__expf(-fabsf(x)));
                    gv = -Aexp * sp; be = 1.0f / (1.0f + __expf(-bv)); }
                float Gc = gv;
#pragma unroll
                for (int o = 1; o < 64; o <<= 1) { const float t = __shfl_up(Gc, o); if (lane >= o) Gc += t; }
                const float G63 = __shfl(Gc, 63);
                Gs[lane] = Gc; eGs[lane] = __expf(Gc); eGls[lane] = __expf(G63 - Gc); bes[lane] = be; }
            if (t0 + 64 < T) GDN_PREFETCH(t0 + 64);
            LBAR();
            {
                const int ln = OPQ(lane), r16 = ln & 15, g4 = ln >> 4;
                const int ti = w >> 1, tj0 = 2 * (w & 1);
                if (tid < 64) { rqs[tid] = rsqrtf(ssq[2 * tid] + RMS6) * 0.08838834764831845f; rks[tid] = rsqrtf(ssq[2 * tid + 1] + RMS6); }
                f32x4 kk[2], qk[2];
#pragma unroll
                for (int c = 0; c < 2; ++c) { kk[c] = (f32x4){0.f, 0.f, 0.f, 0.f}; qk[c] = (f32x4){0.f, 0.f, 0.f, 0.f}; }
#pragma unroll
                for (int ks = 0; ks < 4; ++ks) {
                    const bf16x8 ak = *(const LAS bf16x8*)(kP + (16 * ti + r16) * GQ_STR + 32 * ks + 8 * g4), aq = *(const LAS bf16x8*)(qP + (16 * ti + r16) * GQ_STR + 32 * ks + 8 * g4);
#pragma unroll
                    for (int c = 0; c < 2; ++c) { const bf16x8 bk = *(const LAS bf16x8*)(kP + (16 * (tj0 + c) + r16) * GQ_STR + 32 * ks + 8 * g4);
                        kk[c] = GMFMA(ak, bk, kk[c]); qk[c] = GMFMA(aq, bk, qk[c]); }
                }
#pragma unroll
                for (int c = 0; c < 2; ++c) { const int tj = 16 * (tj0 + c) + r16; const float Gj = Gs[tj]; const int ptj = pperm(tj); const float rkj = rsqrtf(ssq[2 * tj + 1] + RMS6);
#pragma unroll
                    for (int rr = 0; rr < 4; ++rr) { const int tr = 16 * ti + 4 * g4 + rr; const float Gi = Gs[tr];
                        const float rqi = rsqrtf(ssq[2 * tr] + RMS6) * 0.08838834764831845f, rki = rsqrtf(ssq[2 * tr + 1] + RMS6);
                        const float dec = (tr >= tj) ? __expf(Gi - Gj) * rkj : 0.f;
                        Af[tr * AF_STR + tj] = (tr > tj) ? bes[tr] * rki * kk[c][rr] * dec : 0.f;
                        aqP[tr * GT_STR + ptj] = (bf16)(pg8::cvt_pk_bf16(rqi * qk[c][rr] * dec, 0.f) & 0xffffu); }
                }
            }
            LBAR();
            if (w < 4) {
                const int ln = OPQ(lane), c = ln & 15;
                float Ar[16], Tr[16];
#pragma unroll
                for (int i = 0; i < 16; ++i) Ar[i] = Af[(16 * w + i) * AF_STR + 16 * w + c];
                Tr[0] = (c == 0) ? 1.0f : 0.0f;
#pragma unroll
                for (int i = 1; i < 16; ++i) {
                    float acc0 = 0.f, acc1 = 0.f;
#pragma unroll
                    for (int j = 0; j < i; ++j) { const float sv = __builtin_bit_cast(float, __builtin_amdgcn_readlane(__builtin_bit_cast(int, Ar[i]), j));
                        if (j & 1) acc1 += sv * Tr[j]; else acc0 += sv * Tr[j]; }
                    Tr[i] = (c == i) ? 1.0f : -(acc0 + acc1);
                }
                if (ln < 16) {
#pragma unroll
                    for (int i = 0; i < 16; ++i) Xf[(16 * w + i) * AF_STR + 16 * w + c] = Tr[i]; }
            } else {
                const int t2 = OPQ(tid) - 256, zr = t2 >> 4, zc = t2 & 15;
                Xf[(0 + zr) * AF_STR + 16 + zc] = 0.f; Xf[(0 + zr) * AF_STR + 32 + zc] = 0.f; Xf[(0 + zr) * AF_STR + 48 + zc] = 0.f;
                Xf[(16 + zr) * AF_STR + 32 + zc] = 0.f; Xf[(16 + zr) * AF_STR + 48 + zc] = 0.f; Xf[(32 + zr) * AF_STR + 48 + zc] = 0.f;
            }
            LBAR();
#define INV_TASK(bi_, bb_, nterms_) do { const int ln = OPQ(lane), r = ln & 15, g = ln >> 4; const int bi = (bi_), bb = (bb_); \
                f32x4 Pm = (f32x4){0.f, 0.f, 0.f, 0.f}; \
                _Pragma("unroll") for (int jt = 0; jt < (nterms_); ++jt) { const int bj = bb + jt; \
                    const f32x4v a4 = *(const LAS f32x4v*)(Af + (16 * bi + r) * AF_STR + 16 * bj + 4 * g); \
                    const LAS float* bp = Xf + (16 * bj + 4 * g) * AF_STR + 16 * bb + r; \
                    const float b0 = bp[0], b1 = bp[AF_STR], b2 = bp[2 * AF_STR], b3 = bp[3 * AF_STR]; \
                    Pm = __builtin_amdgcn_mfma_f32_16x16x4f32(a4.x, b0, Pm, 0, 0, 0); Pm = __builtin_amdgcn_mfma_f32_16x16x4f32(a4.y, b1, Pm, 0, 0, 0); \
                    Pm = __builtin_amdgcn_mfma_f32_16x16x4f32(a4.z, b2, Pm, 0, 0, 0); Pm = __builtin_amdgcn_mfma_f32_16x16x4f32(a4.w, b3, Pm, 0, 0, 0); } \
                const f32x4v x4 = *(const LAS f32x4v*)(Xf + (16 * bi + r) * AF_STR + 16 * bi + 4 * g); \
                f32x4 Xm = (f32x4){0.f, 0.f, 0.f, 0.f}; \
                Xm = __builtin_amdgcn_mfma_f32_16x16x4f32(x4.x, Pm[0], Xm, 0, 0, 0); Xm = __builtin_amdgcn_mfma_f32_16x16x4f32(x4.y, Pm[1], Xm, 0, 0, 0); \
                Xm = __builtin_amdgcn_mfma_f32_16x16x4f32(x4.z, Pm[2], Xm, 0, 0, 0); Xm = __builtin_amdgcn_mfma_f32_16x16x4f32(x4.w, Pm[3], Xm, 0, 0, 0); \
                LAS float* xo = Xf + (16 * bi + 4 * g) * AF_STR + 16 * bb + r; \
                xo[0] = -Xm[0]; xo[AF_STR] = -Xm[1]; xo[2 * AF_STR] = -Xm[2]; xo[3 * AF_STR] = -Xm[3]; } while (0)
            if (w == 0) { INV_TASK(1, 0, 1); asm volatile("s_waitcnt lgkmcnt(0)" ::: "memory"); INV_TASK(2, 0, 2); asm volatile("s_waitcnt lgkmcnt(0)" ::: "memory"); INV_TASK(3, 0, 3); }
            else if (w == 1) { INV_TASK(2, 1, 1); asm volatile("s_waitcnt lgkmcnt(0)" ::: "memory"); INV_TASK(3, 1, 2); }
            else if (w == 2) { INV_TASK(3, 2, 1); }
            LBAR();
#undef INV_TASK
            { const int td = OPQ(tid), row = td >> 3, c0 = (td & 7) * 8;
              const f32x4v x0 = *(const LAS f32x4v*)(Xf + row * AF_STR + c0), x1 = *(const LAS f32x4v*)(Xf + row * AF_STR + c0 + 4);
              const f32x4v be0 = *(const LAS f32x4v*)(bes + c0), be1 = *(const LAS f32x4v*)(bes + c0 + 4), eg0 = *(const LAS f32x4v*)(eGs + c0), eg1 = *(const LAS f32x4v*)(eGs + c0 + 4);
              const f32x4v rk0 = *(const LAS f32x4v*)(rks + c0), rk1 = *(const LAS f32x4v*)(rks + c0 + 4);
              const f32x4v u0 = x0 * be0, u1 = x1 * be1, w0 = u0 * eg0 * rk0, w1 = u1 * eg1 * rk1;
              u32x2v lo, hi; const int pc = pperm(c0);
              lo.x = pg8::cvt_pk_bf16(u0.x, u0.y); lo.y = pg8::cvt_pk_bf16(u0.z, u0.w); hi.x = pg8::cvt_pk_bf16(u1.x, u1.y); hi.y = pg8::cvt_pk_bf16(u1.z, u1.w);
              *(LAS u32x2v*)(TuP + row * GT_STR + pc) = lo; *(LAS u32x2v*)(TuP + row * GT_STR + pc + 8) = hi;
              lo.x = pg8::cvt_pk_bf16(w0.x, w0.y); lo.y = pg8::cvt_pk_bf16(w0.z, w0.w); hi.x = pg8::cvt_pk_bf16(w1.x, w1.y); hi.y = pg8::cvt_pk_bf16(w1.z, w1.w);
              *(LAS u32x2v*)(TwP + row * GT_STR + pc) = lo; *(LAS u32x2v*)(TwP + row * GT_STR + pc + 8) = hi; }
            LBAR();
            f32x4 ub[4];
            {
                const int ln = OPQ(lane), r16 = ln & 15, g4 = ln >> 4;
                f32x4 wt[4];
#pragma unroll
                for (int tt = 0; tt < 4; ++tt) { ub[tt] = (f32x4){0.f, 0.f, 0.f, 0.f}; wt[tt] = (f32x4){0.f, 0.f, 0.f, 0.f}; }
#pragma unroll
                for (int ks = 0; ks < 2; ++ks) {
                    const bf16x8 bv = *(const LAS bf16x8*)(vT + (16 * w + r16) * GT_STR + (((4 * ks + g4) ^ w) << 3)), ak = *(const LAS bf16x8*)(kT + (16 * w + r16) * GT_STR + (((4 * ks + g4) ^ w) << 3));
#pragma unroll
                    for (int tt = 0; tt < 4; ++tt) { const bf16x8 at = *(const LAS bf16x8*)(TuP + (16 * tt + r16) * GT_STR + 32 * ks + 8 * g4), bt = *(const LAS bf16x8*)(TwP + (16 * tt + r16) * GT_STR + 32 * ks + 8 * g4);
                        ub[tt] = GMFMA(at, bv, ub[tt]); wt[tt] = GMFMA(ak, bt, wt[tt]); }
                }
                const int pd = pperm(16 * w + 4 * g4);
#pragma unroll
                for (int tt = 0; tt < 4; ++tt) { u32x2v o; o.x = pg8::cvt_pk_bf16(-wt[tt][0], -wt[tt][1]); o.y = pg8::cvt_pk_bf16(-wt[tt][2], -wt[tt][3]); *(LAS u32x2v*)(wP + (16 * tt + r16) * GQ_STR + pd) = o; }
            }
            LBAR();
            {
                const int ln = OPQ(lane), r16 = ln & 15, g4 = ln >> 4;
                bf16x8 Sb[4];
#pragma unroll
                for (int ks = 0; ks < 4; ++ks) Sb[ks] = mk8(S[2 * ks][0], S[2 * ks][1], S[2 * ks][2], S[2 * ks][3], S[2 * ks + 1][0], S[2 * ks + 1][1], S[2 * ks + 1][2], S[2 * ks + 1][3]);
                f32x4 u[4], o[4];
#pragma unroll
                for (int tt = 0; tt < 4; ++tt) { u[tt] = ub[tt]; o[tt] = (f32x4){0.f, 0.f, 0.f, 0.f}; }
#pragma unroll
                for (int ks = 0; ks < 4; ++ks)
#pragma unroll
                    for (int tt = 0; tt < 4; ++tt) { const bf16x8 aw = *(const LAS bf16x8*)(wP + (16 * tt + r16) * GQ_STR + 32 * ks + 8 * g4), aq = *(const LAS bf16x8*)(qP + (16 * tt + r16) * GQ_STR + 32 * ks + 8 * g4);
                        u[tt] = GMFMA(aw, Sb[ks], u[tt]); o[tt] = GMFMA(aq, Sb[ks], o[tt]); }
#pragma unroll
                for (int tt = 0; tt < 4; ++tt)
#pragma unroll
                    for (int rr = 0; rr < 4; ++rr) o[tt][rr] *= eGs[16 * tt + 4 * g4 + rr] * rqs[16 * tt + 4 * g4 + rr];
                bf16x8 Ub[2], Us[2];
#pragma unroll
                for (int ks = 0; ks < 2; ++ks) {
                    Ub[ks] = mk8(u[2 * ks][0], u[2 * ks][1], u[2 * ks][2], u[2 * ks][3], u[2 * ks + 1][0], u[2 * ks + 1][1], u[2 * ks + 1][2], u[2 * ks + 1][3]);
                    float e[8];
#pragma unroll
                    for (int rr = 0; rr < 4; ++rr) { e[rr] = u[2 * ks][rr] * (eGls[32 * ks + 4 * g4 + rr] * rks[32 * ks + 4 * g4 + rr]); e[4 + rr] = u[2 * ks + 1][rr] * (eGls[32 * ks + 16 + 4 * g4 + rr] * rks[32 * ks + 16 + 4 * g4 + rr]); }
                    Us[ks] = mk8(e[0], e[1], e[2], e[3], e[4], e[5], e[6], e[7]);
                }
#pragma unroll
                for (int ks = 0; ks < 2; ++ks)
#pragma unroll
                    for (int tt = 0; tt < 4; ++tt) { const bf16x8 aa = *(const LAS bf16x8*)(aqP + (16 * tt + r16) * GT_STR + 32 * ks + 8 * g4); o[tt] = GMFMA(aa, Ub[ks], o[tt]); }
                const float cd = eGs[63];
#pragma unroll
                for (int dt = 0; dt < 8; ++dt) { S[dt] = S[dt] * cd;
#pragma unroll
                    for (int ks = 0; ks < 2; ++ks) { const bf16x8 ak = *(const LAS bf16x8*)(kT + (16 * dt + r16) * GT_STR + (((4 * ks + g4) ^ dt) << 3)); S[dt] = GMFMA(ak, Us[ks], S[dt]); } }
#pragma unroll
                for (int tt = 0; tt < 4; ++tt)
#pragma unroll
                    for (int rr = 0; rr < 4; ++rr) os[(16 * tt + 4 * g4 + rr) * 128 + 16 * w + r16] = o[tt][rr];
            }
            LBAR();
            { const int td = OPQ(tid), r = td >> 3, j = td & 7;
              if (r < TB) { float ov[16]; float ss = 0.f;
#pragma unroll
                for (int i = 0; i < 4; ++i) { const f32x4v t4 = *(const LAS f32x4v*)(os + r * 128 + j * 16 + 4 * i); ov[4 * i] = t4.x; ov[4 * i + 1] = t4.y; ov[4 * i + 2] = t4.z; ov[4 * i + 3] = t4.w; ss += (t4.x * t4.x + t4.y * t4.y) + (t4.z * t4.z + t4.w * t4.w); }
                ss += __shfl_xor(ss, 1); ss += __shfl_xor(ss, 2); ss += __shfl_xor(ss, 4);
                const float rs = rsqrtf(ss * (1.0f / 128.0f) + RMS6);
                const size_t row = rowb + t0 + r; float gt[16];
                unpack8(gt0, gt); unpack8(gt1, gt + 8);
                const float* onw = a.in[I_ONW] + j * 16;
#pragma unroll
                for (int i = 0; i < 16; ++i) ov[i] = ov[i] * rs * onw[i] * siluf(gt[i]);
                *(GAS v4u*)(og + row * D + h * 128 + j * 16) = pack8(ov); *(GAS v4u*)(og + row * D + h * 128 + j * 16 + 8) = pack8(ov + 8); }
            }
        }
        { const int ln = OPQ(lane), r16 = ln & 15, g4 = ln >> 4; float* so = a.out + (samp ? O_DSS : O_DSP) + (((size_t)n * 32 + h) * 128) * 128;
#pragma unroll
          for (int dt = 0; dt < 8; ++dt)
#pragma unroll
              for (int rr = 0; rr < 4; ++rr) so[(size_t)(16 * dt + 4 * g4 + rr) * 128 + 16 * w + r16] = S[dt][rr]; }
    }
}
#undef GMFMA
#undef LBAR
#undef GDN_PREFETCH

__device__ __forceinline__ void final_phase(const Frame& F, const Args& a) {
    const float* ssq = (const float*)(a.ws + WS_SSQ) + 4 * (size_t)M; const float* g = a.in[I_FNORM];
    const int gw = F.vcu * NWAVES + F.wave, NGW = F.G * NWAVES;
    for (int m = gw; m < M; m += NGW) {
        float* yr = a.out + O_Y + (size_t)m * D; const float rs = rsqrtf(ssq[m] * (1.0f / D) + RMS6);
#pragma unroll
        for (int j = 0; j < 16; ++j) { const int c = j * 256 + F.lane * 4; f32x4v v = *(const f32x4v*)(yr + c); const f32x4v gg = *(const f32x4v*)(g + c);
            v.x = v.x * rs * gg.x; v.y = v.y * rs * gg.y; v.z = v.z * rs * gg.z; v.w = v.w * rs * gg.w; *(f32x4v*)(yr + c) = v; }
    }
}

__device__ __forceinline__ void ssq_reduce(const Frame& F, const float* part, float* ssq) {
    for (int b = F.vcu; b < NP / 64; b += F.G) { const int row = 64 * b + (F.tid >> 3), j = F.tid & 7;
        const f32x4v p0 = *(const f32x4v*)(part + (size_t)row * 64 + 8 * j), p1 = *(const f32x4v*)(part + (size_t)row * 64 + 8 * j + 4);
        float s = ((p0.x + p0.y) + (p0.z + p0.w)) + ((p1.x + p1.y) + (p1.z + p1.w));
        s += __shfl_xor(s, 1); s += __shfl_xor(s, 2); s += __shfl_xor(s, 4);
        if (j == 0) ssq[row] = s; }
}
__device__ __forceinline__ void sample_finalize(const Frame& F, const float* slab, int nsplit, const float* base_f, const bf16* base_b, float* out_f, bf16* out_b, float* ssq) {
    LAS float* red = (LAS float*)(F.lds + SMALL_OFF);
    for (int r = F.vcu; r < 256; r += F.G) {
        const int c0 = F.tid * 8, pn = c0 >> 8, cc = c0 & 255;
        f32x4v a0, a1;
        if (base_f) { a0 = *(const f32x4v*)(base_f + (size_t)r * D + c0); a1 = *(const f32x4v*)(base_f + (size_t)r * D + c0 + 4); }
        else { float t[8]; unpack8(*(const GAS v4u*)(base_b + (size_t)r * D + c0), t); a0 = (f32x4v){t[0], t[1], t[2], t[3]}; a1 = (f32x4v){t[4], t[5], t[6], t[7]}; }
        for (int ks = 0; ks < nsplit; ++ks) { const float* sp = slab + ((size_t)(pn * nsplit + ks) * 256 + r) * 256 + cc; a0 = a0 + *(const f32x4v*)sp; a1 = a1 + *(const f32x4v*)(sp + 4); }
        if (out_f) { *(f32x4v*)(out_f + (size_t)r * D + c0) = a0; *(f32x4v*)(out_f + (size_t)r * D + c0 + 4) = a1; }
        if (out_b) { v4u o; o.x = pk2(a0.x, a0.y); o.y = pk2(a0.z, a0.w); o.z = pk2(a1.x, a1.y); o.w = pk2(a1.z, a1.w); *(GAS v4u*)(out_b + (size_t)r * D + c0) = o; }
        float s = (a0.x * a0.x + a0.y * a0.y) + (a0.z * a0.z + a0.w * a0.w) + (a1.x * a1.x + a1.y * a1.y) + (a1.z * a1.z + a1.w * a1.w);
        s = wave_sum(s);
        __syncthreads();
        if (F.lane == 0) red[F.wave] = s;
        __syncthreads();
        if (F.tid == 0) { float t = 0.f;
#pragma unroll
            for (int i = 0; i < NWAVES; ++i) t += red[i];
            ssq[r] = t; }
    }
}
__device__ __forceinline__ void sample_finalize_up(const Frame& F, const float* slab, const float* ssq, bf16* hid) {
    for (int r = F.vcu; r < 256; r += F.G) {
        const float rs = rsqrtf(ssq[r] * (1.0f / D) + RMS6);
#pragma unroll
        for (int it = 0; it < 4; ++it) { const int c0 = (it * 512 + F.tid) * 8, pn = c0 >> 8, cc = c0 & 255;
            f32x4v a0 = (f32x4v){0.f, 0.f, 0.f, 0.f}, a1 = a0;
#pragma unroll
            for (int ks = 0; ks < 4; ++ks) { const float* sp = slab + ((size_t)(pn * 4 + ks) * 256 + r) * 256 + cc; a0 = a0 + *(const f32x4v*)sp; a1 = a1 + *(const f32x4v*)(sp + 4); }
            float z[8] = {a0.x, a0.y, a0.z, a0.w, a1.x, a1.y, a1.z, a1.w};
#pragma unroll
            for (int i = 0; i < 8; ++i) { const float t = fmaxf(z[i] * rs, 0.f); z[i] = t * t; }
            *(GAS v4u*)(hid + (size_t)r * DFF + c0) = pack8(z); }
    }
}

__device__ __forceinline__ int claim_unit(const Frame& F, unsigned* ctr) {
    volatile LAS unsigned* MISC = (volatile LAS unsigned*)(F.lds + MISC_OFF);
    if (F.tid == 0) MISC[24] = __hip_atomic_fetch_add(ctr, 1u, __ATOMIC_RELAXED, __HIP_MEMORY_SCOPE_AGENT);
    __syncthreads(); const unsigned j = MISC[24]; __syncthreads();
    return __builtin_amdgcn_readfirstlane((int)j);
}
__global__ void __launch_bounds__(NWAVES * 64, 2) mk_fwd(Args args) {
    extern __shared__ __attribute__((aligned(16))) unsigned char lds[];
    Frame F;
    F.lds = (LAS unsigned char*)lds;
    volatile LAS unsigned* MISC = (volatile LAS unsigned*)(F.lds + MISC_OFF);
    F.tid = threadIdx.x; F.lane = F.tid & 63; F.wave = __builtin_amdgcn_readfirstlane(F.tid >> 6);
    F.G = gridDim.x; { const int bx = blockIdx.x; F.vcu = (F.G % 8 == 0) ? (bx % 8) * (F.G / 8) + bx / 8 : bx; }
    unsigned char* ws = args.ws;
    if (F.tid < 64) MISC[F.tid] = 0u;
    __syncthreads();
    XcdBarrier bar; bar.bar = (unsigned*)(ws + WS_CTL) + CW_BAR; bar.x = 0; bar.st = nullptr;
    if (MK_N_LAUNCHES == 1) bar = xcd_barrier_post((unsigned*)(ws + WS_CTL) + CW_BAR, MISC + 8);
    const int lo = args.ph_lo, hi = args.ph_hi;
#define IN(k) (lo <= (k) && (k) < hi)
#define SEAM(k) do { if (IN(k) && IN((k) + 1)) xcd_barrier(bar); } while (0)
#define xcd_barrier_always(b, lo_, hi_, k_) xcd_barrier(b)
    float* ssqb = (float*)(ws + WS_SSQ); float* slab = (float*)(ws + WS_SLAB); float* ssqp = (float*)(ws + WS_SSQP);
    bf16* xb = (bf16*)(ws + WS_XB); bf16* mixb = (bf16*)(ws + WS_MIX); bf16* big = (bf16*)(ws + WS_BIG);

    if (IN(0)) { p0_prologue(F, args); } SEAM(0);
    if (IN(1)) {
        const bool split_roles = (F.G == 256);
        if (!split_roles || (int)blockIdx.x < 224) {
            pg8::Gemm g{xb, (const bf16*)(ws + WS_WINA), M, IN0, D, D}; pg8::StaticOrder S; S.init(M, IN0, split_roles ? 224 : F.G, (int)blockIdx.x);
            pg8::EpiRow<0> E{big, IN0, ssqb, nullptr, -1};
            pg8::gemm_phase<pg8::EpiRow<0>, pg8::StaticOrder, true, true>(F.lds, g, S, E);
        }
        for (;;) { const int q = claim_unit(F, (unsigned*)(ws + WS_CTL) + CW_CLAIM + 7) + CW_P0; if (q >= CW_END) break; conv_chunk(F, args, q); }
    } SEAM(1);
    if (IN(2)) { attn_phase(F, args); } SEAM(2);
    if (IN(3)) {
        { pg8::Gemm g{mixb, (const bf16*)(ws + WS_WOUTA), NP, D, 4096, 4096}; pg8::StaticOrder S; S.init(NP, D, F.G, (int)blockIdx.x);
          pg8::EpiRes<false, false> E{xb, xb, ssqp};
          pg8::gemm_phase<pg8::EpiRes<false, false>, pg8::StaticOrder, true, true>(F.lds, g, S, E); }
        { pg8::Gemm g{mixb + (size_t)NP * 4096, (const bf16*)(ws + WS_WOUTA), 256, D, 256, 4096}; pg8::EpiSlab E{slab, 16};
          for (;;) { const int j = claim_unit(F, (unsigned*)(ws + WS_CTL) + CW_CLAIM + 0); if (j >= (D / 256) * 16) break;
              pg8::SplitOrder S{D / 256, 16, 1 << 24, j};
              pg8::gemm_phase<pg8::EpiSlab, pg8::SplitOrder, true, true>(F.lds, g, S, E); } }
        xcd_barrier_always(bar, lo, hi, 3);
        ssq_reduce(F, ssqp, ssqb + 1 * (size_t)M);
        sample_finalize(F, slab, 16, nullptr, xb + (size_t)NP * D, nullptr, xb + (size_t)NP * D, ssqb + 1 * (size_t)M + NP);
    } SEAM(3);
    if (IN(4)) {
        { pg8::Gemm g{xb, (const bf16*)(ws + WS_WUP), NP, DFF, D, D}; pg8::StaticOrder S; S.init(NP, DFF, F.G, (int)blockIdx.x);
          pg8::EpiRow<1> E{big, DFF, ssqb + 1 * (size_t)M, nullptr, -1};
          pg8::gemm_phase<pg8::EpiRow<1>, pg8::StaticOrder, true, true>(F.lds, g, S, E); }
        { pg8::Gemm g{xb + (size_t)NP * D, (const bf16*)(ws + WS_WUP), 256, DFF, 1024, D}; pg8::EpiSlab E{slab, 4};
          for (;;) { const int j = claim_unit(F, (unsigned*)(ws + WS_CTL) + CW_CLAIM + 1); if (j >= (DFF / 256) * 4) break;
              pg8::SplitOrder S{DFF / 256, 4, 1 << 24, j};
              pg8::gemm_phase<pg8::EpiSlab, pg8::SplitOrder, true, true>(F.lds, g, S, E); } }
        xcd_barrier(bar);
        sample_finalize_up(F, slab, ssqb + 1 * (size_t)M + NP, big + (size_t)NP * DFF);
    } SEAM(4);
    if (IN(5)) {
        { pg8::Gemm g{big, (const bf16*)(ws + WS_WDN), NP, D, 16384, 16384}; pg8::StaticOrder S; S.init(NP, D, F.G, (int)blockIdx.x);
          pg8::EpiRes<false, false> E{xb, xb, ssqp};
          pg8::gemm_phase<pg8::EpiRes<false, false>, pg8::StaticOrder, true, true>(F.lds, g, S, E); }
        { pg8::Gemm g{big + (size_t)NP * 16384, (const bf16*)(ws + WS_WDN), 256, D, 1024, 16384}; pg8::EpiSlab E{slab, 16};
          for (;;) { const int j = claim_unit(F, (unsigned*)(ws + WS_CTL) + CW_CLAIM + 2); if (j >= (D / 256) * 16) break;
              pg8::SplitOrder S{D / 256, 16, 1 << 24, j};
              pg8::gemm_phase<pg8::EpiSlab, pg8::SplitOrder, true, true>(F.lds, g, S, E); } }
        xcd_barrier_always(bar, lo, hi, 5);
        ssq_reduce(F, ssqp, ssqb + 2 * (size_t)M);
        sample_finalize(F, slab, 16, nullptr, xb + (size_t)NP * D, nullptr, xb + (size_t)NP * D, ssqb + 2 * (size_t)M + NP);
    } SEAM(5);
    if (IN(6)) {
        pg8::Gemm g{xb, (const bf16*)(ws + WS_WING), M, IN1P, D, D}; pg8::StaticOrder S; S.init(M, IN1P, F.G, (int)blockIdx.x);
        pg8::EpiRow<0> E{big, IN1M, ssqb + 2 * (size_t)M, (float*)(ws + WS_AUX), 64};
        pg8::gemm_phase<pg8::EpiRow<0>, pg8::StaticOrder, true, true>(F.lds, g, S, E);
        if (F.G == 256 && (int)blockIdx.x >= DEF_WG6) p0_deferred(F, args, 6, (int)blockIdx.x - DEF_WG6);
    } SEAM(6);
    if (IN(7)) { gdn_phase(F, args); } SEAM(7);
    if (IN(8)) {
        { pg8::Gemm g{mixb, (const bf16*)(ws + WS_WOUTG), NP, D, 4096, 4096}; pg8::StaticOrder S; S.init(NP, D, F.G, (int)blockIdx.x);
          pg8::EpiRes<false, false> E{xb, xb, ssqp};
          pg8::gemm_phase<pg8::EpiRes<false, false>, pg8::StaticOrder, true, true>(F.lds, g, S, E); }
        { pg8::Gemm g{mixb + (size_t)NP * 4096, (const bf16*)(ws + WS_WOUTG), 256, D, 256, 4096}; pg8::EpiSlab E{slab, 16};
          for (;;) { const int j = claim_unit(F, (unsigned*)(ws + WS_CTL) + CW_CLAIM + 3); if (j >= (D / 256) * 16) break;
              pg8::SplitOrder S{D / 256, 16, 1 << 24, j};
              pg8::gemm_phase<pg8::EpiSlab, pg8::SplitOrder, true, true>(F.lds, g, S, E); } }
        xcd_barrier_always(bar, lo, hi, 8);
        ssq_reduce(F, ssqp, ssqb + 3 * (size_t)M);
        sample_finalize(F, slab, 16, nullptr, xb + (size_t)NP * D, nullptr, xb + (size_t)NP * D, ssqb + 3 * (size_t)M + NP);
    } SEAM(8);
    if (IN(9)) {
        { pg8::Gemm g{xb, (const bf16*)(ws + WS_WUP) + (size_t)DFF * D, NP, DFF, D, D}; pg8::StaticOrder S; S.init(NP, DFF, F.G, (int)blockIdx.x);
          pg8::EpiRow<1> E{big, DFF, ssqb + 3 * (size_t)M, nullptr, -1};
          pg8::gemm_phase<pg8::EpiRow<1>, pg8::StaticOrder, true, true>(F.lds, g, S, E); }
        { pg8::Gemm g{xb + (size_t)NP * D, (const bf16*)(ws + WS_WUP) + (size_t)DFF * D, 256, DFF, 1024, D}; pg8::EpiSlab E{slab, 4};
          for (;;) { const int j = claim_unit(F, (unsigned*)(ws + WS_CTL) + CW_CLAIM + 4); if (j >= (DFF / 256) * 4) break;
              pg8::SplitOrder S{DFF / 256, 4, 1 << 24, j};
              pg8::gemm_phase<pg8::EpiSlab, pg8::SplitOrder, true, true>(F.lds, g, S, E); } }
        xcd_barrier(bar);
        sample_finalize_up(F, slab, ssqb + 3 * (size_t)M + NP, big + (size_t)NP * DFF);
    } SEAM(9);
    if (IN(10)) {
        { pg8::Gemm g{big, (const bf16*)(ws + WS_WDN) + (size_t)D * DFF, NP, D, 16384, 16384}; pg8::StaticOrder S; S.init(NP, D, F.G, (int)blockIdx.x);
          pg8::EpiRes<false, true> E{xb, (args.out + O_Y), ssqp};
          pg8::gemm_phase<pg8::EpiRes<false, true>, pg8::StaticOrder, true, true>(F.lds, g, S, E); }
        { pg8::Gemm g{big + (size_t)NP * 16384, (const bf16*)(ws + WS_WDN) + (size_t)D * DFF, 256, D, 1024, 16384}; pg8::EpiSlab E{slab, 16};
          for (;;) { const int j = claim_unit(F, (unsigned*)(ws + WS_CTL) + CW_CLAIM + 5); if (j >= (D / 256) * 16) break;
              pg8::SplitOrder S{D / 256, 16, 1 << 24, j};
              pg8::gemm_phase<pg8::EpiSlab, pg8::SplitOrder, true, true>(F.lds, g, S, E); } }
        xcd_barrier_always(bar, lo, hi, 10);
        ssq_reduce(F, ssqp, ssqb + 4 * (size_t)M);
        sample_finalize(F, slab, 16, nullptr, xb + (size_t)NP * D, (args.out + O_Y) + (size_t)NP * D, nullptr, ssqb + 4 * (size_t)M + NP);
    } SEAM(10);
    if (IN(11)) { final_phase(F, args); }
#undef IN
#undef SEAM
}

extern "C" void kernel_launch(void* const* d_in, const int* in_sizes, int n_in, void* d_out, int out_size, void* d_ws, size_t ws_size, hipStream_t stream) {
    static int grid = 0;
    if (grid == 0) {
        if (n_in != 23 || in_sizes[0] != NP * D || (size_t)out_size != O_END || ws_size < WS_END) {
            fprintf(stderr, "kernel_launch: unexpected shapes: n_in %d in0 %d out %d (want %zu) ws %zu (want %zu); nothing launched\n", n_in, n_in > 0 ? in_sizes[0] : -1, out_size, (size_t)O_END, ws_size, (size_t)WS_END); grid = -1; return; }
        int dev = 0, cus = 0, per_cu = 0;
        if (hipGetDevice(&dev) != hipSuccess || hipDeviceGetAttribute(&cus, hipDeviceAttributeMultiprocessorCount, dev) != hipSuccess) { fprintf(stderr, "kernel_launch: device query failed\n"); grid = -1; return; }
        if (hipFuncSetAttribute((const void*)mk_fwd, hipFuncAttributeMaxDynamicSharedMemorySize, LDS_BYTES) != hipSuccess) { fprintf(stderr, "kernel_launch: hipFuncSetAttribute failed\n"); grid = -1; return; }
        if (hipOccupancyMaxActiveBlocksPerMultiprocessor(&per_cu, (const void*)mk_fwd, NWAVES * 64, LDS_BYTES) != hipSuccess || per_cu < 1)
            fprintf(stderr, "kernel_launch: note: occupancy query reports %d workgroups per CU\n", per_cu);
        (void)hipGetLastError();
        grid = cus;
    }
    if (grid < 0) return;
    if (hipMemsetAsync((char*)d_ws + WS_CTL, 0, CTL_ZERO_BYTES, stream) != hipSuccess) { fprintf(stderr, "kernel_launch: memset failed\n"); return; }
    Args a{};
    for (int i = 0; i < 23; ++i) a.in[i] = (const float*)d_in[i];
    a.out = (float*)d_out; a.ws = (unsigned char*)d_ws;
    if (MK_N_LAUNCHES == 1) { a.ph_lo = 0; a.ph_hi = N_PHASES; hipLaunchKernelGGL(mk_fwd, dim3(grid), dim3(NWAVES * 64), LDS_BYTES, stream, a); }
    else { for (int p = 0; p < N_PHASES; ++p) { a.ph_lo = p; a.ph_hi = p + 1; hipLaunchKernelGGL(mk_fwd, dim3(grid), dim3(NWAVES * 64), LDS_BYTES, stream, a); } }
    const hipError_t le = hipPeekAtLastError();
    if (le != hipSuccess) fprintf(stderr, "kernel_launch: launch failed: %s\n", hipGetErrorName(le));
}
```

```cpp
#include <hip/hip_runtime.h>
#include <cstdio>
#include <cstdint>
namespace pg8 {
#define PG8_LAS __attribute__((address_space(3)))
typedef unsigned short bf16_t;
typedef short bf16x8 __attribute__((ext_vector_type(8)));
typedef float f32x4 __attribute__((ext_vector_type(4)));
typedef unsigned u32x4 __attribute__((ext_vector_type(4)));
constexpr int BM = 256, BK = 64, HALF = 128, HTB = HALF * BK * 2  , STAGE_BYTES = 8 * HTB, NXCD = 8, WGM = 8;

__host__ __device__ __forceinline__ int lds_byte(int r, int c) { const int st = (r >> 4) * 2 + (c >> 5), rr = r & 15, cc = c & 31, ob = rr * 64 + cc * 2; return st * 1024 + (ob ^ (((ob >> 9) & 1) << 5)); }
__host__ __device__ __forceinline__ void stage_rc(int b, int& R, int& C) { const int st = b / 1024, sb = b % 1024, swz = sb ^ (((sb >> 9) & 1) << 5); R = (st >> 1) * 16 + swz / 64; C = (st & 1) * 32 + (swz % 64) / 2; }
__host__ __device__ __forceinline__ int perm32(int rho) { const int n = rho >> 4, i = rho & 15; return 8 * (i >> 2) + 4 * n + (i & 3); }

struct Unit { int pm, pn, ks; };
struct Gemm { const bf16_t* A; const bf16_t* Bt; int M, N, K, ldk; };

struct StaticOrder {
    int nM, nN, nwg, G, c;
    __host__ __device__ void init(int M, int N, int G_, int c_) { nM = M / BM; nN = N / BM; nwg = nM * nN; G = G_; c = c_; }
    __host__ __device__ bool next(int i, Unit& u) const {
        const long L = (long)i * G + c; if (L >= nwg) return false;
        int wgid = (int)L; { const int q = nwg / NXCD, r = nwg % NXCD, xcd = wgid % NXCD, off = wgid / NXCD; wgid = (xcd < r ? xcd * (q + 1) : r * (q + 1) + (xcd - r) * q) + off; }
        const int nig = WGM * nN, gid = wgid / nig, fm = gid * WGM, gsz = (nM - fm) < WGM ? (nM - fm) : WGM;
        u.pm = fm + ((wgid % nig) % gsz); u.pn = (wgid % nig) / gsz; u.ks = 0; return true;
    }
    __device__ __forceinline__ void a_ready(const Unit&) const {}
    __device__ __forceinline__ void done(const Unit&) const {}
};


typedef float cvt_f32x2 __attribute__((ext_vector_type(2)));
typedef __bf16 cvt_bf16x2 __attribute__((ext_vector_type(2)));
__device__ __forceinline__ unsigned cvt_pk_bf16(float lo, float hi) { const cvt_f32x2 v = {lo, hi}; return __builtin_bit_cast(unsigned, __builtin_convertvector(v, cvt_bf16x2)); }
constexpr float RMS_EPS = 1e-6f;
constexpr int DMODEL = 4096;
template <int ACT> struct EpiRow {
    static constexpr bool PERM = true, AFTER_DRAIN = false;
    bf16_t* O; int ldc; const float* ssq; float* aux; int pn_aux;
    __device__ __forceinline__ void operator()(const f32x4 (&acc)[2][2][4][2], const Unit& u, int wr, int wc, int fr, int fq) const {
        const int row0 = u.pm * BM + wr * 64 + fr, ct = wc * 32 + 8 * fq;
        const bool isaux = (u.pn == pn_aux);
#pragma unroll
        for (int ai = 0; ai < 2; ++ai)
#pragma unroll
            for (int m = 0; m < 4; ++m) {
                const int row = row0 + ai * HALF + m * 16;
                const float rs = rsqrtf(ssq[row] * (1.0f / DMODEL) + RMS_EPS);
#pragma unroll
                for (int bj = 0; bj < 2; ++bj) {
                    f32x4 v0 = acc[ai][bj][m][0] * rs, v1 = acc[ai][bj][m][1] * rs;
                    if (ACT == 1) {
#pragma unroll
                        for (int j = 0; j < 4; ++j) { const float a = fmaxf(v0[j], 0.f), b = fmaxf(v1[j], 0.f); v0[j] = a * a; v1[j] = b * b; }
                    }
                    if (isaux) {
                        if (bj == 0 && ct < 64) { float* p = aux + (size_t)row * 64 + ct; *(f32x4*)p = v0; *(f32x4*)(p + 4) = v1; }
                    } else {
                        u32x4 w; w.x = cvt_pk_bf16(v0[0], v0[1]); w.y = cvt_pk_bf16(v0[2], v0[3]); w.z = cvt_pk_bf16(v1[0], v1[1]); w.w = cvt_pk_bf16(v1[2], v1[3]);
                        *(u32x4*)(O + (size_t)row * ldc + u.pn * BM + ct + bj * HALF) = w;
                    }
                }
            }
    }
};
struct SplitOrder {
    int nN, nsplit, G, c;
    __device__ bool next(int i, Unit& u) const { const int L = i * G + c; if (L >= nN * nsplit) return false; u.pm = 0; u.pn = L / nsplit; u.ks = L % nsplit; return true; }
    __device__ __forceinline__ void a_ready(const Unit&) const {}
    __device__ __forceinline__ void done(const Unit&) const {}
};
struct EpiSlab {
    static constexpr bool PERM = false, AFTER_DRAIN = false;
    float* slab; int nsplit;
    __device__ __forceinline__ void operator()(const f32x4 (&acc)[2][2][4][2], const Unit& u, int wr, int wc, int fr, int fq) const {
        float* sb = slab + (size_t)(u.pn * nsplit + u.ks) * 65536 + (size_t)(wr * 64 + fr) * 256 + wc * 32 + 4 * fq;
#pragma unroll
        for (int ai = 0; ai < 2; ++ai)
#pragma unroll
            for (int m = 0; m < 4; ++m)
#pragma unroll
                for (int bj = 0; bj < 2; ++bj)
#pragma unroll
                    for (int n = 0; n < 2; ++n) *(f32x4*)(sb + (size_t)(ai * HALF + m * 16) * 256 + bj * HALF + n * 16) = acc[ai][bj][m][n];
    }
};
template <bool BASE_F32, bool OUT_F32> struct EpiRes {
    static constexpr bool PERM = true, AFTER_DRAIN = false;
    const void* base; void* out; float* ssq;
    __device__ __forceinline__ void operator()(const f32x4 (&acc)[2][2][4][2], const Unit& u, int wr, int wc, int fr, int fq) const {
        const int row0 = u.pm * BM + wr * 64 + fr, col0 = u.pn * BM + wc * 32 + 8 * fq;
#pragma unroll
        for (int ai = 0; ai < 2; ++ai)
#pragma unroll
            for (int m = 0; m < 4; ++m) {
                const int row = row0 + ai * HALF + m * 16; const size_t off = (size_t)row * DMODEL + col0;
                float s = 0.f;
#pragma unroll
                for (int bj = 0; bj < 2; ++bj) {
                    f32x4 b0, b1;
                    if (BASE_F32) { b0 = *(const f32x4*)((const float*)base + off + bj * HALF); b1 = *(const f32x4*)((const float*)base + off + bj * HALF + 4); }
                    else { const u32x4 w = *(const u32x4*)((const bf16_t*)base + off + bj * HALF);
                        b0[0] = __builtin_bit_cast(float, w.x << 16); b0[1] = __builtin_bit_cast(float, w.x & 0xffff0000u); b0[2] = __builtin_bit_cast(float, w.y << 16); b0[3] = __builtin_bit_cast(float, w.y & 0xffff0000u);
                        b1[0] = __builtin_bit_cast(float, w.z << 16); b1[1] = __builtin_bit_cast(float, w.z & 0xffff0000u); b1[2] = __builtin_bit_cast(float, w.w << 16); b1[3] = __builtin_bit_cast(float, w.w & 0xffff0000u); }
                    const f32x4 o0 = b0 + acc[ai][bj][m][0], o1 = b1 + acc[ai][bj][m][1];
                    s += ((o0[0] * o0[0] + o0[1] * o0[1]) + (o0[2] * o0[2] + o0[3] * o0[3])) + ((o1[0] * o1[0] + o1[1] * o1[1]) + (o1[2] * o1[2] + o1[3] * o1[3]));
                    if (OUT_F32) { *(f32x4*)((float*)out + off + bj * HALF) = o0; *(f32x4*)((float*)out + off + bj * HALF + 4) = o1; }
                    else { u32x4 w; w.x = cvt_pk_bf16(o0[0], o0[1]); w.y = cvt_pk_bf16(o0[2], o0[3]); w.z = cvt_pk_bf16(o1[0], o1[1]); w.w = cvt_pk_bf16(o1[2], o1[3]); *(u32x4*)((bf16_t*)out + off + bj * HALF) = w; }
                }
                s += __shfl_xor(s, 16); s += __shfl_xor(s, 32);
                if (fq == 0) ssq[(size_t)row * 64 + u.pn * 4 + wc] = s;
            }
    }
};
__device__ __forceinline__ __amdgpu_buffer_rsrc_t mk_rsrc(const void* p) {
    const unsigned lo = __builtin_amdgcn_readfirstlane((unsigned)(size_t)p), hi = __builtin_amdgcn_readfirstlane((unsigned)((size_t)p >> 32));
    return __builtin_amdgcn_make_buffer_rsrc((void*)(((size_t)hi << 32) | lo), 0, 0xFFFFF000u, 0x00020000);
}
template <class Epi, class Sched, bool ALIGN_EPI = false, bool SP2 = false>
__device__ __forceinline__ void gemm_phase(PG8_LAS unsigned char* lds, const Gemm g, const Sched& S, const Epi& E) {
    const int tid = threadIdx.x, wid = __builtin_amdgcn_readfirstlane(tid >> 6), lane = tid & 63, wr = wid >> 2, wc = wid & 3, fr = lane & 15, fq = lane >> 4;
    const int K = g.K, nt = K / BK;
    unsigned voffA[2], voffB[2];
#pragma unroll
    for (int i = 0; i < 2; ++i) { int R, C; stage_rc(tid * 16 + i * 8192, R, C); const int Rb = Epi::PERM ? ((R & ~31) + perm32(R & 31)) : R;
        voffA[i] = (unsigned)(R * g.ldk + C) * 2u; voffB[i] = (unsigned)(Rb * g.ldk + C) * 2u; }
    const unsigned kstep = (unsigned)(BK * 2);
    const unsigned hstep = (unsigned)(HALF * g.ldk * 2);
    const unsigned tstep = 2 * hstep;
    const unsigned ldsw = (unsigned)wid * 1024u;
    const int aoff = lds_byte(wr * 64 + fr, fq * 8), boff = lds_byte(wc * 32 + fr, fq * 8);
#define PG8_SA(b, h) (((b) * 2 + (h)) * HTB)
#define PG8_SB(b, h) ((4 + (b) * 2 + (h)) * HTB)
    const __amdgpu_buffer_rsrc_t rs_voffA = mk_rsrc(g.A), rs_voffB = mk_rsrc(g.Bt);
#define PG8_STAGE(bufoff, soff, voff) do { _Pragma("unroll") for (int _i = 0; _i < 2; ++_i) \
        __builtin_amdgcn_raw_ptr_buffer_load_lds(rs_##voff, (PG8_LAS void*)(lds + (bufoff) + ldsw + _i * 8192), 16, (voff)[_i], (soff), 0, 0); } while (0)
#define PG8_LDA(dst, b, h) do { _Pragma("unroll") for (int m = 0; m < 4; ++m) _Pragma("unroll") for (int k = 0; k < 2; ++k) dst[m][k] = *(const PG8_LAS bf16x8*)(lds + PG8_SA(b, h) + aoff + m * 2048 + k * 1024); } while (0)
#define PG8_LDB(dst, b, h) do { _Pragma("unroll") for (int n = 0; n < 2; ++n) _Pragma("unroll") for (int k = 0; k < 2; ++k) dst[n][k] = *(const PG8_LAS bf16x8*)(lds + PG8_SB(b, h) + boff + n * 2048 + k * 1024); } while (0)
#define PG8_MMA(ai, bj, At, Bt) do { __builtin_amdgcn_s_setprio(1); _Pragma("unroll") for (int m = 0; m < 4; ++m) _Pragma("unroll") for (int n = 0; n < 2; ++n) _Pragma("unroll") for (int k = 0; k < 2; ++k) \
        acc[ai][bj][m][n] = __builtin_amdgcn_mfma_f32_16x16x32_bf16(Bt[n][k], At[m][k], acc[ai][bj][m][n], 0, 0, 0); __builtin_amdgcn_s_setprio(0); } while (0)
#define PG8_WAIT_V(n) asm volatile("s_waitcnt vmcnt(" #n ")" ::: "memory")
#define PG8_WAIT_L(n) asm volatile("s_waitcnt lgkmcnt(" #n ")" ::: "memory")
#define PG8_BAR __builtin_amdgcn_s_barrier()
#define PG8_SCHED __builtin_amdgcn_sched_barrier(0)
    Unit cur, nxt; int ui = 0;
    if (!S.next(0, cur)) return;
    f32x4 acc[2][2][4][2];
#pragma unroll
    for (int a = 0; a < 2; ++a)
#pragma unroll
        for (int b = 0; b < 2; ++b)
#pragma unroll
            for (int m = 0; m < 4; ++m)
#pragma unroll
                for (int n = 0; n < 2; ++n) acc[a][b][m][n] = (f32x4){0.f, 0.f, 0.f, 0.f};
    bf16x8 At[4][2], B0[2][2], B1[2][2];
    unsigned cA = (unsigned)cur.pm * tstep + (unsigned)(cur.ks * K * 2), cB = (unsigned)cur.pn * tstep + (unsigned)(cur.ks * K * 2);
    S.a_ready(cur);
    if constexpr (SP2) {
        PG8_STAGE(PG8_SB(0, 0), cB, voffB); PG8_STAGE(PG8_SB(0, 1), cB + hstep, voffB); PG8_STAGE(PG8_SA(0, 0), cA, voffA); PG8_STAGE(PG8_SA(0, 1), cA + hstep, voffA);
        if (wr == 1) PG8_BAR;
        PG8_WAIT_V(2); PG8_BAR;
        PG8_STAGE(PG8_SB(1, 0), cB + kstep, voffB); PG8_STAGE(PG8_SA(1, 0), cA + kstep, voffA); PG8_STAGE(PG8_SB(1, 1), cB + hstep + kstep, voffB);
        PG8_WAIT_V(6); PG8_BAR;
    } else {
        PG8_STAGE(PG8_SB(0, 0), cB, voffB); PG8_STAGE(PG8_SA(0, 0), cA, voffA); PG8_STAGE(PG8_SB(0, 1), cB + hstep, voffB); PG8_STAGE(PG8_SA(0, 1), cA + hstep, voffA);
        if (wr == 1) PG8_BAR;
        PG8_WAIT_V(4); PG8_BAR;
        PG8_STAGE(PG8_SB(1, 0), cB + kstep, voffB); PG8_STAGE(PG8_SA(1, 0), cA + kstep, voffA); PG8_STAGE(PG8_SB(1, 1), cB + hstep + kstep, voffB);
        PG8_WAIT_V(6); PG8_BAR;
    }
    for (;;) {
        const bool has_next = S.next(ui + 1, nxt);
        const unsigned nA = has_next ? (unsigned)nxt.pm * tstep + (unsigned)(nxt.ks * K * 2) : cA, nB = has_next ? (unsigned)nxt.pn * tstep + (unsigned)(nxt.ks * K * 2) : cB;
        for (int t = 0; t < nt; t += 2) {
            const bool last = (t == nt - 2);
            const unsigned a1 = cA + (unsigned)(t + 1) * kstep;
            const unsigned a2 = last ? nA : cA + (unsigned)(t + 2) * kstep, b2 = last ? nB : cB + (unsigned)(t + 2) * kstep;
            const unsigned a3 = a2 + kstep, b3 = b2 + kstep;
            if (last && has_next) S.a_ready(nxt);
            if constexpr (SP2) {
            PG8_LDB(B0, 0, 0); PG8_LDB(B1, 0, 1); PG8_SCHED; PG8_LDA(At, 0, 0); PG8_STAGE(PG8_SA(1, 1), a1 + hstep, voffA);
            PG8_WAIT_V(8); PG8_WAIT_L(0); PG8_BAR; PG8_MMA(0, 0, At, B0); PG8_MMA(0, 1, At, B1); PG8_BAR; PG8_SCHED;
            PG8_LDA(At, 0, 1); PG8_STAGE(PG8_SB(0, 0), b2, voffB); PG8_STAGE(PG8_SB(0, 1), b2 + hstep, voffB); PG8_STAGE(PG8_SA(0, 0), a2, voffA);
            PG8_WAIT_V(8); PG8_WAIT_L(0); PG8_BAR; PG8_MMA(1, 0, At, B0); PG8_MMA(1, 1, At, B1); PG8_BAR; PG8_SCHED;
            PG8_LDB(B0, 1, 0); PG8_LDB(B1, 1, 1); PG8_SCHED; PG8_LDA(At, 1, 0); PG8_STAGE(PG8_SA(0, 1), a2 + hstep, voffA);
            PG8_WAIT_V(8); PG8_WAIT_L(0); PG8_BAR; PG8_MMA(0, 0, At, B0); PG8_MMA(0, 1, At, B1); PG8_BAR; PG8_SCHED;
            PG8_LDA(At, 1, 1); PG8_STAGE(PG8_SB(1, 0), b3, voffB); PG8_STAGE(PG8_SB(1, 1), b3 + hstep, voffB); PG8_STAGE(PG8_SA(1, 0), a3, voffA);
            PG8_WAIT_V(8); PG8_WAIT_L(0); PG8_BAR; PG8_MMA(1, 0, At, B0); PG8_MMA(1, 1, At, B1); PG8_BAR; PG8_SCHED;
            } else {
            PG8_LDB(B0, 0, 0); PG8_SCHED; PG8_LDA(At, 0, 0); PG8_STAGE(PG8_SA(1, 1), a1 + hstep, voffA);
            PG8_WAIT_L(8); PG8_BAR; PG8_WAIT_L(0); PG8_MMA(0, 0, At, B0); PG8_BAR; PG8_SCHED;
            PG8_LDB(B1, 0, 1); PG8_STAGE(PG8_SB(0, 0), b2, voffB);
            PG8_BAR; PG8_WAIT_L(0); PG8_MMA(0, 1, At, B1); PG8_BAR;
            PG8_LDA(At, 0, 1); PG8_STAGE(PG8_SA(0, 0), a2, voffA);
            PG8_BAR; PG8_WAIT_L(0); PG8_MMA(1, 0, At, B0); PG8_BAR; PG8_SCHED;
            PG8_STAGE(PG8_SB(0, 1), b2 + hstep, voffB);
            PG8_WAIT_V(6); PG8_BAR; PG8_MMA(1, 1, At, B1); PG8_BAR;
            PG8_LDB(B0, 1, 0); PG8_SCHED; PG8_LDA(At, 1, 0); PG8_STAGE(PG8_SA(0, 1), a2 + hstep, voffA);
            PG8_WAIT_L(8); PG8_BAR; PG8_WAIT_L(0); PG8_MMA(0, 0, At, B0); PG8_BAR; PG8_SCHED;
            PG8_LDB(B1, 1, 1); PG8_STAGE(PG8_SB(1, 0), b3, voffB);
            PG8_BAR; PG8_WAIT_L(0); PG8_MMA(0, 1, At, B1); PG8_BAR;
            PG8_LDA(At, 1, 1); PG8_STAGE(PG8_SA(1, 0), a3, voffA);
            PG8_BAR; PG8_WAIT_L(0); PG8_MMA(1, 0, At, B0); PG8_BAR; PG8_SCHED;
            PG8_STAGE(PG8_SB(1, 1), b3 + hstep, voffB);
            PG8_WAIT_V(6); PG8_BAR; PG8_MMA(1, 1, At, B1); PG8_BAR;
            }
        }
        if constexpr (ALIGN_EPI) { if (wr == 0) PG8_BAR; }
        if constexpr (!Epi::AFTER_DRAIN) { E(acc, cur, wr, wc, fr, fq); S.done(cur); }
        if (!has_next) break;
#pragma unroll
        for (int a = 0; a < 2; ++a)
#pragma unroll
            for (int b = 0; b < 2; ++b)
#pragma unroll
                for (int m = 0; m < 4; ++m)
#pragma unroll
                    for (int n = 0; n < 2; ++n) acc[a][b][m][n] = (f32x4){0.f, 0.f, 0.f, 0.f};
        cur = nxt; cA = nA; cB = nB; ++ui;
        if constexpr (ALIGN_EPI) { if (wr == 1) PG8_BAR; }
    }
    PG8_WAIT_V(0);
    if constexpr (!ALIGN_EPI) { if (wr == 0) PG8_BAR; }
    PG8_BAR;
    if constexpr (Epi::AFTER_DRAIN) { E.fused(acc, cur, wr, wc, fr, fq, lds, wid, lane); S.done(cur); }
#undef PG8_SA
#undef PG8_SB
#undef PG8_STAGE
#undef PG8_LDA
#undef PG8_LDB
#undef PG8_MMA
#undef PG8_WAIT_V
#undef PG8_WAIT_L
#undef PG8_BAR
#undef PG8_SCHED
}
}

#define GAS __attribute__((address_space(1)))
#define LAS __attribute__((address_space(3)))
typedef unsigned short bf16;
typedef unsigned v4u __attribute__((ext_vector_type(4)));
typedef float f32x4 __attribute__((ext_vector_type(4)));
typedef short bf16x8 __attribute__((ext_vector_type(8)));
typedef GAS unsigned gu32;
typedef GAS unsigned long long gu64;
#define RLX_AGENT __ATOMIC_RELAXED, __HIP_MEMORY_SCOPE_AGENT
#define LDS_WAIT() asm volatile("s_waitcnt lgkmcnt(0)" ::: "memory")
#define VM_WAIT() asm volatile("s_waitcnt vmcnt(0)" ::: "memory")
__device__ __forceinline__ unsigned long long rt() { return __builtin_amdgcn_s_memrealtime(); }
__device__ __forceinline__ unsigned f2bf(float f) { unsigned u = __builtin_bit_cast(unsigned, f); return (u + 0x7fffu + ((u >> 16) & 1u)) >> 16; }
__device__ __forceinline__ unsigned pk2(float lo, float hi) { return pg8::cvt_pk_bf16(lo, hi); }

#define XB_TMO      128
#define XB_XCNT(j)  (256  + 64 * (j))
#define XB_XSUB(j)  (1280 + 64 * (j))
#define XB_XGEN(j)  (2304 + 64 * (j))
#define XB_TOP      3328
#define XB_TOPGEN   3392
#define XCD_BAR_WORDS 3456
#define XB_SPIN_CAP (1u << 18)

__device__ __forceinline__ unsigned xb_ld(unsigned* p)              { return __hip_atomic_load(p, __ATOMIC_RELAXED, __HIP_MEMORY_SCOPE_AGENT); }
__device__ __forceinline__ unsigned xb_add(unsigned* p, unsigned v) { return __hip_atomic_fetch_add(p, v, __ATOMIC_RELAXED, __HIP_MEMORY_SCOPE_AGENT); }
__device__ __forceinline__ unsigned xb_xcc_id() { return (unsigned)__builtin_amdgcn_s_getreg((3 << 11) | 20) & 0xFu; }
#define XB_SPIN(cond, bar) do { unsigned _sp = 0; while (cond) { __builtin_amdgcn_s_sleep(1); \
    if ((++_sp & 255u) == 0u) { if (xb_ld(&(bar)[XB_TMO])) break; if (_sp > XB_SPIN_CAP) { atomicAdd(&(bar)[XB_TMO], 1u); break; } } } } while (0)

struct XcdBarrier {
    unsigned* bar; unsigned x;
    volatile LAS unsigned* st;
};

__device__ __forceinline__ XcdBarrier xcd_barrier_post(unsigned* bar, volatile LAS unsigned* st) {
    XcdBarrier b; b.bar = bar; b.x = xb_xcc_id(); b.st = st;
    if (threadIdx.x == 0) (void)xb_add(&bar[XB_XCNT(b.x)], 1u);
    return b;
}
__device__ __forceinline__ void xcd_barrier_complete(unsigned* bar, unsigned x, unsigned& nloc, unsigned& nx) {
    const unsigned G = gridDim.x * gridDim.y * gridDim.z;
    unsigned sum, cnt, mine, sp = 0u;
    for (;;) {
        sum = 0u; cnt = 0u; mine = 0u;
#pragma unroll
        for (unsigned j = 0; j < 16; ++j) { const unsigned c = xb_ld(&bar[XB_XCNT(j)]); sum += c; cnt += (c > 0u) ? 1u : 0u; mine = (j == x) ? c : mine; }
        if (sum == G) break;
        __builtin_amdgcn_s_sleep(1);
        if ((++sp & 255u) == 0u) { if (xb_ld(&bar[XB_TMO])) break; if (sp > XB_SPIN_CAP) { atomicAdd(&bar[XB_TMO], 1u); break; } }
    }
    nloc = mine > 0u ? mine : 1u; nx = cnt > 0u ? cnt : 1u;
}

__device__ __forceinline__ void xcd_barrier(const XcdBarrier& b) {
    asm volatile("s_waitcnt vmcnt(0)" ::: "memory");
    __syncthreads();
    if (threadIdx.x == 0) {
        unsigned* bar = b.bar;
        __builtin_amdgcn_s_waitcnt(0);
        unsigned nloc = b.st[0], nx = b.st[1];
        if (nloc == 0u) { xcd_barrier_complete(bar, b.x, nloc, nx); b.st[0] = nloc; b.st[1] = nx; }
        const unsigned old = xb_add(&bar[XB_XSUB(b.x)], 1u);
        const unsigned gen = old / nloc;
        if (old + 1u == (gen + 1u) * nloc) {
            __builtin_amdgcn_fence(__ATOMIC_RELEASE, "agent");
            asm volatile("s_waitcnt vmcnt(0)" ::: "memory");
            const unsigned og = xb_add(&bar[XB_TOP], 1u);
            const unsigned tg = og / nx;
            if (og + 1u == (tg + 1u) * nx) xb_add(&bar[XB_TOPGEN], 1u);
            else XB_SPIN(xb_ld(&bar[XB_TOPGEN]) == tg, bar);
            __builtin_amdgcn_fence(__ATOMIC_ACQUIRE, "agent");
            xb_add(&bar[XB_XGEN(b.x)], 1u);
            asm volatile("s_waitcnt vmcnt(0)" ::: "memory");
        } else {
            XB_SPIN(xb_ld(&bar[XB_XGEN(b.x)]) == gen, bar);
            __builtin_amdgcn_fence(__ATOMIC_ACQUIRE, "agent");
            asm volatile("s_waitcnt vmcnt(0)" ::: "memory");
        }
    }
    __syncthreads();
}

constexpr int NWAVES = 8;
#ifndef MK_N_LAUNCHES
#define MK_N_LAUNCHES 1
#endif
constexpr int N_PHASES = 12;
constexpr int D = 4096, SEQ = 2048, NB = 8, NSB = 16, NST = 16, PAST = 4096;
constexpr int NP = NB * SEQ;
constexpr int M = NP + NSB * NST;
constexpr int IN0 = 8704, IN1 = 16448, IN1M = 16384, IN1P = 16640, DFF = 16384;
constexpr int C_K = 2048, C_V = 2304, C_B = 2560, C_C = 4608, C_X = 6656;
constexpr int NH = 32, HD = 64, NKV = 4, GDH = 128, QKV = 12288;
constexpr size_t MiB = 1u << 20;
constexpr size_t WS_CTL = 0, CTL_ZERO_BYTES = 64 * 1024;
constexpr size_t WS_SSQ = 1 * MiB;
constexpr size_t WS_ROPE = 2 * MiB;
constexpr size_t WS_AUX = 3 * MiB;
constexpr size_t WS_WINA = 8 * MiB;
constexpr size_t WS_WOUTA = WS_WINA + 68 * MiB;
constexpr size_t WS_WING = WS_WOUTA + 32 * MiB;
constexpr size_t WS_WOUTG = WS_WING + 130 * MiB;
constexpr size_t WS_WUP = WS_WOUTG + 32 * MiB;
constexpr size_t WS_WDN = WS_WUP + 256 * MiB;
constexpr size_t WS_XB = WS_WDN + 256 * MiB;
constexpr size_t WS_MIX = WS_XB + 130 * MiB;
constexpr size_t WS_XRES = WS_MIX + 130 * MiB;
constexpr size_t WS_BIG = WS_XRES + 260 * MiB;
constexpr size_t WS_SLAB = WS_BIG + 520 * MiB;
constexpr size_t WS_SSQP = WS_SLAB + 64 * MiB;
constexpr size_t WS_END = WS_SSQP + 4 * MiB;
static_assert((size_t)M * D * 2 <= 130 * MiB && (size_t)M * D * 4 <= 260 * MiB && (size_t)M * DFF * 2 <= 520 * MiB && (size_t)IN1P * D * 2 <= 130 * MiB, "ws map");
constexpr int CW_CLAIM = 12032;
constexpr int CW_BAR = 4096;
constexpr int RING_BYTES = 131072;
constexpr int LDS_BYTES = 147456;
constexpr int MISC_OFF = LDS_BYTES - 256;
constexpr int SMALL_OFF = 133120;

typedef float f32x4v __attribute__((ext_vector_type(4)));
constexpr float RMS6 = 1e-6f;
__device__ __forceinline__ float bf2f(unsigned short b) { return __builtin_bit_cast(float, (unsigned)b << 16); }
__device__ __forceinline__ void unpack8(const v4u w, float* f) {
    f[0] = __builtin_bit_cast(float, w.x << 16); f[1] = __builtin_bit_cast(float, w.x & 0xffff0000u);
    f[2] = __builtin_bit_cast(float, w.y << 16); f[3] = __builtin_bit_cast(float, w.y & 0xffff0000u);
    f[4] = __builtin_bit_cast(float, w.z << 16); f[5] = __builtin_bit_cast(float, w.z & 0xffff0000u);
    f[6] = __builtin_bit_cast(float, w.w << 16); f[7] = __builtin_bit_cast(float, w.w & 0xffff0000u);
}
__device__ __forceinline__ v4u pack8(const float* f) { v4u o; o.x = pk2(f[0], f[1]); o.y = pk2(f[2], f[3]); o.z = pk2(f[4], f[5]); o.w = pk2(f[6], f[7]); return o; }
__device__ __forceinline__ float wave_sum(float v) {
#pragma unroll
    for (int o = 1; o < 64; o <<= 1) v += __shfl_xor(v, o);
    return v;
}
__device__ __forceinline__ float siluf(float x) { return x * __builtin_amdgcn_rcpf(1.0f + __expf(-x)); }

struct Args { const float* in[23]; float* out; unsigned char* ws; int ph_lo, ph_hi; };
enum { I_XP = 0, I_XS, I_CK, I_CV, I_SSC, I_SDC, I_SDN, I_ANORM, I_WINA, I_SINKS, I_SCW, I_WOUTA, I_DNORM, I_WING, I_DCW, I_ALOG, I_DTB, I_ONW, I_WOUTG, I_MNORM, I_WUP, I_WDN, I_FNORM };
constexpr size_t O_Y = 0;
constexpr size_t O_KP = (size_t)M * D;
constexpr size_t O_VP = O_KP + 8 * 128 * 256;
constexpr size_t O_KS = O_VP + 8 * 128 * 256;
constexpr size_t O_VS = O_KS + 16 * 128 * 256;
constexpr size_t O_CP = O_VS + 16 * 128 * 256;
constexpr size_t O_CS = O_CP + 8 * 2 * 2048;
constexpr size_t O_DCP = O_CS + 16 * 2 * 2048;
constexpr size_t O_DCS = O_DCP + 8 * 3 * 12288;
constexpr size_t O_DSP = O_DCS + 16 * 3 * 12288;
constexpr size_t O_DSS = O_DSP + (size_t)8 * 32 * 128 * 128;
constexpr size_t O_END = O_DSS + (size_t)16 * 32 * 128 * 128;

struct Frame {
    LAS unsigned char* lds; int tid, lane, wave, vcu, G;
};
constexpr int DEF_Q1 = 168, DEF_Q6 = 128, DEF_WG1 = 162, DEF_WG6 = 129, DEF_N1 = (256 - DEF_WG1) * DEF_Q1, DEF_N6 = (256 - DEF_WG6) * DEF_Q6;
static_assert(DEF_N1 <= 256 * 64 && DEF_N6 <= 64 * 256, "deferred items inside one layer's matrix");

__device__ __forceinline__ void p0_item(const float* W, int ldw, const float* gain, bf16* WT, int K, int k0, int n0, LAS float* scr, int lane) {
#pragma unroll 4
    for (int i = 0; i < 16; ++i) { const int kk = 4 * i + (lane >> 4);
        f32x4v v = __builtin_nontemporal_load((const f32x4v*)(W + (size_t)(k0 + kk) * ldw + n0 + 4 * (lane & 15)));
        const float g = gain ? gain[k0 + kk] : 1.0f; LAS float* s = scr + kk * 65 + 4 * (lane & 15);
        s[0] = v.x * g; s[1] = v.y * g; s[2] = v.z * g; s[3] = v.w * g; }
    LDS_WAIT(); asm volatile("" ::: "memory");
    const int c = lane & 7;
#pragma unroll
    for (int j = 0; j < 8; ++j) { const int n = (lane >> 3) + 8 * j; const LAS float* s = scr + (8 * c) * 65 + n;
        v4u o; o.x = pk2(s[0 * 65], s[1 * 65]); o.y = pk2(s[2 * 65], s[3 * 65]); o.z = pk2(s[4 * 65], s[5 * 65]); o.w = pk2(s[6 * 65], s[7 * 65]);
        *(GAS v4u*)(WT + (size_t)(n0 + n) * K + k0 + 8 * c) = o; }
    LDS_WAIT(); asm volatile("" ::: "memory");
}
constexpr int CW_S1 = 64, CW_S2 = CW_S1 + 256, CW_S3 = CW_S2 + 256, CW_S4 = CW_S3 + 257, CW_S5 = CW_S4 + 64, CW_S6 = CW_S5 + (16384 - DEF_N6) / 64, CW_END = CW_S6 + 256;
static_assert((16384 - DEF_N6) % 64 == 0, "the w_up[1] tail is whole chunks");
#ifndef CW_P0
#define CW_P0 0
#endif
__device__ __forceinline__ void conv_chunk(const Frame& F, const Args& a, int q) {
    LAS float* scr = (LAS float*)(F.lds + F.wave * 16640);
    const int lane = F.lane, c8 = lane & 7;
    const float* W; const float* gain = nullptr; bf16* WT; int ldw, K, ncol, r0;
    if (q < CW_S1)      { W = a.in[I_WOUTA]; WT = (bf16*)(a.ws + WS_WOUTA); ldw = D; K = D; ncol = 64; r0 = q * 64; }
    else if (q < CW_S2) { W = a.in[I_WUP]; gain = a.in[I_MNORM]; WT = (bf16*)(a.ws + WS_WUP); ldw = DFF; K = D; ncol = 256; r0 = (q - CW_S1) * 64; }
    else if (q < CW_S3) { W = a.in[I_WDN]; WT = (bf16*)(a.ws + WS_WDN); ldw = D; K = DFF; ncol = 64; r0 = (q - CW_S2) * 64; }
    else if (q < CW_S4) { W = a.in[I_WING]; gain = a.in[I_DNORM]; WT = (bf16*)(a.ws + WS_WING); ldw = IN1; K = D; ncol = 257; r0 = (q - CW_S3) * 64; }
    else if (q < CW_S5) { W = a.in[I_WOUTG]; WT = (bf16*)(a.ws + WS_WOUTG); ldw = D; K = D; ncol = 64; r0 = (q - CW_S4) * 64; }
    else if (q < CW_S6) { W = a.in[I_WUP] + (size_t)D * DFF; gain = a.in[I_MNORM] + D; WT = (bf16*)(a.ws + WS_WUP) + (size_t)DFF * D; ldw = DFF; K = D; ncol = 256; r0 = DEF_N6 + (q - CW_S5) * 64; }
    else                { W = a.in[I_WDN] + (size_t)DFF * D; WT = (bf16*)(a.ws + WS_WDN) + (size_t)D * DFF; ldw = D; K = DFF; ncol = 64; r0 = (q - CW_S6) * 64; }
    f32x4v buf[16];
    int r = r0 + F.wave; int k0 = 64 * (r / ncol), n0 = 64 * (r % ncol);
#pragma unroll
    for (int i = 0; i < 16; ++i) buf[i] = __builtin_nontemporal_load((const f32x4v*)(W + (size_t)(k0 + 4 * i + (lane >> 4)) * ldw + n0 + 4 * (lane & 15)));
    for (int it = 0; it < 8; ++it) {
#pragma unroll
        for (int i = 0; i < 16; ++i) { LAS float* s = scr + (4 * i + (lane >> 4)) * 65 + 4 * (lane & 15); s[0] = buf[i].x; s[1] = buf[i].y; s[2] = buf[i].z; s[3] = buf[i].w; }
        const int mk0 = k0, mn0 = n0;
        f32x4v g0 = (f32x4v){1.f, 1.f, 1.f, 1.f}, g1 = g0;
        if (gain) { g0 = *(const f32x4v*)(gain + mk0 + 8 * c8); g1 = *(const f32x4v*)(gain + mk0 + 8 * c8 + 4); }
        if (it + 1 < 8) { r += NWAVES; k0 = 64 * (r / ncol); n0 = 64 * (r % ncol);
#pragma unroll
            for (int i = 0; i < 16; ++i) buf[i] = __builtin_nontemporal_load((const f32x4v*)(W + (size_t)(k0 + 4 * i + (lane >> 4)) * ldw + n0 + 4 * (lane & 15))); }
        LDS_WAIT(); asm volatile("" ::: "memory");
#pragma unroll
        for (int jj = 0; jj < 8; ++jj) { const int n = (lane >> 3) + 8 * jj; const LAS float* s = scr + (8 * c8) * 65 + n;
            v4u o; o.x = pk2(s[0 * 65] * g0.x, s[1 * 65] * g0.y); o.y = pk2(s[2 * 65] * g0.z, s[3 * 65] * g0.w); o.z = pk2(s[4 * 65] * g1.x, s[5 * 65] * g1.y); o.w = pk2(s[6 * 65] * g1.z, s[7 * 65] * g1.w);
            __builtin_nontemporal_store(o, (GAS v4u*)(WT + (size_t)(mn0 + n) * K + mk0 + 8 * c8)); }
        LDS_WAIT(); asm volatile("" ::: "memory");
    }
}
__device__ __forceinline__ double rope_inv(int i) {
    return i == 0 ? 1.0 : i == 1 ? 0.19392274474868576 : i == 2 ? 0.03760603093086393 : i == 3 ? 0.007292664737217109 : i == 4 ? 0.001414213562373095 :
           i == 5 ? 0.0002742481756762073 : i == 6 ? 5.318295896944988e-05 : 1.031338537721246e-05;
}
__device__ __forceinline__ void p0_prologue(const Frame& F, const Args& a) {
    unsigned char* ws = a.ws;
    LAS float* scr = (LAS float*)(F.lds + F.wave * 16640);
    const int gw = F.vcu * NWAVES + F.wave, NGW = F.G * NWAVES;
    for (int r = gw; r < 64 * 136; r += NGW) p0_item(a.in[I_WINA], IN0, a.in[I_ANORM], (bf16*)(ws + WS_WINA), D, 64 * (r / 136), 64 * (r % 136), scr, F.lane);
    if (F.G != 256) for (int r = gw; r < DEF_N6; r += NGW) p0_item(a.in[I_WUP] + (size_t)D * DFF, DFF, a.in[I_MNORM] + D, (bf16*)(ws + WS_WUP) + (size_t)DFF * D, D, 64 * (r / 256), 64 * (r % 256), scr, F.lane);
    for (int q = F.vcu; q < CW_P0; q += F.G) conv_chunk(F, a, q);
    { GAS v4u* z = (GAS v4u*)((bf16*)(ws + WS_WING) + (size_t)IN1 * D); const int nz = (IN1P - IN1) * D / 8;
      for (int i = gw * 64 + F.lane; i < nz; i += NGW * 64) z[i] = (v4u){0u, 0u, 0u, 0u}; }
    float* ssq0 = (float*)(ws + WS_SSQ);
    for (int m = gw; m < M; m += NGW) {
        const float* xr = (m < NP) ? a.in[I_XP] + (size_t)m * D : a.in[I_XS] + (size_t)(m - NP) * D;
        bf16* ob = (bf16*)(ws + WS_XB) + (size_t)m * D;
        float s = 0.f;
#pragma unroll
        for (int j = 0; j < 8; ++j) {
            const f32x4v v0 = __builtin_nontemporal_load((const f32x4v*)(xr + j * 512 + F.lane * 8)), v1 = __builtin_nontemporal_load((const f32x4v*)(xr + j * 512 + F.lane * 8 + 4));
            s += (v0.x * v0.x + v0.y * v0.y) + (v0.z * v0.z + v0.w * v0.w) + (v1.x * v1.x + v1.y * v1.y) + (v1.z * v1.z + v1.w * v1.w);
            v4u o; o.x = pk2(v0.x, v0.y); o.y = pk2(v0.z, v0.w); o.z = pk2(v1.x, v1.y); o.w = pk2(v1.z, v1.w);
            *(GAS v4u*)(ob + j * 512 + F.lane * 8) = o;
        }
        s = wave_sum(s);
        if (F.lane == 0) ssq0[m] = s;
    }
    float* rope = (float*)(ws + WS_ROPE);
    for (int i = (F.vcu * NWAVES * 64) + F.tid; i < 2064 * 8; i += F.G * NWAVES * 64) {
        const int pi = i >> 3, fi = i & 7; const int pos = pi < 2048 ? pi : PAST + (pi - 2048);
        const float angf = (float)pos * (float)rope_inv(fi);
        double rev = (double)angf * 0.15915494309189535; rev -= __builtin_rint(rev);
        const float r = (float)rev;
        rope[pi * 16 + fi] = __builtin_amdgcn_cosf(r); rope[pi * 16 + 8 + fi] = __builtin_amdgcn_sinf(r);
    }
}

__device__ __forceinline__ int pperm(int x) { return (x & ~31) | ((x & 12) << 1) | ((x & 16) >> 2) | (x & 3); }
__device__ __forceinline__ int cswz(int pcol, int m) { return (((pcol >> 3) ^ m) << 3) | (pcol & 7); }
typedef unsigned u32x2v __attribute__((ext_vector_type(2)));
__device__ __forceinline__ bf16x8 mk8(float a0, float a1, float a2, float a3, float a4, float a5, float a6, float a7) {
    v4u t; t.x = pg8::cvt_pk_bf16(a0, a1); t.y = pg8::cvt_pk_bf16(a2, a3); t.z = pg8::cvt_pk_bf16(a4, a5); t.w = pg8::cvt_pk_bf16(a6, a7); return __builtin_bit_cast(bf16x8, t); }
#define OPQ(v_) ({ int _t = (v_); asm volatile("" : "+v"(_t)); _t; })
__device__ __forceinline__ void p0_deferred(const Frame& F, const Args& a, int which, int j) {
    LAS float* scr = (LAS float*)(F.lds + F.wave * 16640);
    const int lane = F.lane, c8 = lane & 7;
    const float* W; const float* gain; bf16* WT; int ldw, K, ncol;
    if (which == 1) { W = a.in[I_WDN] + (size_t)DFF * D; gain = nullptr; WT = (bf16*)(a.ws + WS_WDN) + (size_t)D * DFF; ldw = D; K = DFF; ncol = 64; }
    else            { W = a.in[I_WUP] + (size_t)D * DFF; gain = a.in[I_MNORM] + D; WT = (bf16*)(a.ws + WS_WUP) + (size_t)DFF * D; ldw = DFF; K = D; ncol = 256; }
    f32x4v buf[16];
    const int DEF_Q = (which == 1) ? DEF_Q1 : DEF_Q6;
    int r = j * DEF_Q + F.wave; int k0 = 64 * (r / ncol), n0 = 64 * (r % ncol);
#pragma unroll
    for (int i = 0; i < 16; ++i) buf[i] = __builtin_nontemporal_load((const f32x4v*)(W + (size_t)(k0 + 4 * i + (lane >> 4)) * ldw + n0 + 4 * (lane & 15)));
    for (int q = F.wave; q < DEF_Q; q += NWAVES) {
#pragma unroll
        for (int i = 0; i < 16; ++i) { LAS float* s = scr + (4 * i + (lane >> 4)) * 65 + 4 * (lane & 15); s[0] = buf[i].x; s[1] = buf[i].y; s[2] = buf[i].z; s[3] = buf[i].w; }
        const int mk0 = k0, mn0 = n0;
        f32x4v g0 = (f32x4v){1.f, 1.f, 1.f, 1.f}, g1 = g0;
        if (gain) { g0 = *(const f32x4v*)(gain + mk0 + 8 * c8); g1 = *(const f32x4v*)(gain + mk0 + 8 * c8 + 4); }
        if (q + NWAVES < DEF_Q) { r += NWAVES; k0 = 64 * (r / ncol); n0 = 64 * (r % ncol);
#pragma unroll
            for (int i = 0; i < 16; ++i) buf[i] = __builtin_nontemporal_load((const f32x4v*)(W + (size_t)(k0 + 4 * i + (lane >> 4)) * ldw + n0 + 4 * (lane & 15))); }
        LDS_WAIT(); asm volatile("" ::: "memory");
#pragma unroll
        for (int jj = 0; jj < 8; ++jj) { const int n = (lane >> 3) + 8 * jj; const LAS float* s = scr + (8 * c8) * 65 + n;
            v4u o; o.x = pk2(s[0 * 65] * g0.x, s[1 * 65] * g0.y); o.y = pk2(s[2 * 65] * g0.z, s[3 * 65] * g0.w); o.z = pk2(s[4 * 65] * g1.x, s[5 * 65] * g1.y); o.w = pk2(s[6 * 65] * g1.z, s[7 * 65] * g1.w);
            __builtin_nontemporal_store(o, (GAS v4u*)(WT + (size_t)(mn0 + n) * K + mk0 + 8 * c8)); }
        LDS_WAIT(); asm volatile("" ::: "memory");
    }
}
__device__ __forceinline__ void rope8(float* mine, const float* other, const float* cs, bool second) {
#pragma unroll
    for (int i = 0; i < 8; ++i) mine[i] = second ? (mine[i] * cs[i] + other[i] * cs[8 + i]) : (mine[i] * cs[i] - other[i] * cs[8 + i]);
}
__device__ __forceinline__ void attn_phase(const Frame& F, const Args& a) {
    unsigned char* ws = a.ws;
    const bf16* proj = (const bf16*)(ws + WS_BIG); bf16* mix = (bf16*)(ws + WS_MIX);
    const float* rope = (const float*)(ws + WS_ROPE);
    constexpr int AK_STR = 72, AV_STR = 200;
    LAS bf16* kN = (LAS bf16*)F.lds; LAS bf16* vT = kN + 192 * AK_STR;
    const int tid = F.tid, lane = F.lane, w = F.wave;
    constexpr int NU = 1024 + 64;
#define AMFMA(A_, B_, C_) __builtin_amdgcn_mfma_f32_16x16x32_bf16((A_), (B_), (C_), 0, 0, 0)
    for (int u = F.vcu; u < NU; u += F.G) {
        const bool samp = u >= 1024;
        int n, c, kvh, kb0, nvalid;
        if (!samp) { n = u >> 7; c = (u >> 2) & 31; kvh = u & 3; kb0 = c >= 2 ? 0 : (2 - c); nvalid = 192; }
        else { const int v = u - 1024; n = v >> 2; c = 0; kvh = v & 3; kb0 = 0; nvalid = 144; }
        const int head = kvh * 8 + w;
        v4u kraw[3], vraw[3], qraw[2][2][2];
        { const int td = OPQ(tid);
#pragma unroll
          for (int it = 0; it < 3; ++it) { const int slot = it * 512 + td, j = slot >> 3, ch = slot & 7, pos = (c - 2) * 64 + j;
              kraw[it] = (v4u){0u, 0u, 0u, 0u}; vraw[it] = kraw[it];
              if (!samp && pos >= 0) { const bf16* r = proj + ((size_t)n * SEQ + pos) * IN0 + kvh * 64 + ch * 8; kraw[it] = *(const GAS v4u*)(r + C_K); vraw[it] = *(const GAS v4u*)(r + C_V); } }
          const int ln = OPQ(lane), r16 = ln & 15, g4 = ln >> 4;
#pragma unroll
          for (int qh = 0; qh < 2; ++qh)
#pragma unroll
              for (int qt = 0; qt < 2; ++qt) { const int ql = qh * 32 + qt * 16 + r16;
                  const size_t qr = samp ? (size_t)NP + n * NST + r16 : (size_t)n * SEQ + c * 64 + ql;
                  const bf16* qp = proj + qr * IN0 + head * 64 + 8 * g4; qraw[qh][qt][0] = *(const GAS v4u*)qp; qraw[qh][qt][1] = *(const GAS v4u*)(qp + 32); } }
        __syncthreads();
#pragma unroll
        for (int it = 0; it < 3; ++it) {
            const int slot = it * 512 + OPQ(tid), j = slot >> 3, ch = slot & 7;
            float kf[8], vf[8]; bool rot = false; int pi = 0;
#pragma unroll
            for (int i = 0; i < 8; ++i) { kf[i] = 0.f; vf[i] = 0.f; }
            if (!samp) {
                const int pos = (c - 2) * 64 + j;
                if (pos >= 0) { unpack8(kraw[it], kf); unpack8(vraw[it], vf); rot = true; pi = pos; }
            } else {
                if (j < 128) { const size_t o = (((size_t)n * 128 + j) * 4 + kvh) * 64 + ch * 8;
                    const f32x4v k0 = *(const f32x4v*)(a.in[I_CK] + o), k1 = *(const f32x4v*)(a.in[I_CK] + o + 4), v0 = *(const f32x4v*)(a.in[I_CV] + o), v1 = *(const f32x4v*)(a.in[I_CV] + o + 4);
                    kf[0] = k0.x; kf[1] = k0.y; kf[2] = k0.z; kf[3] = k0.w; kf[4] = k1.x; kf[5] = k1.y; kf[6] = k1.z; kf[7] = k1.w;
                    vf[0] = v0.x; vf[1] = v0.y; vf[2] = v0.z; vf[3] = v0.w; vf[4] = v1.x; vf[5] = v1.y; vf[6] = v1.z; vf[7] = v1.w; }
                else if (j < 144) { const bf16* r = proj + ((size_t)NP + n * NST + (j - 128)) * IN0 + kvh * 64 + ch * 8;
                    unpack8(*(const GAS v4u*)(r + C_K), kf); unpack8(*(const GAS v4u*)(r + C_V), vf); rot = true; pi = 2048 + (j - 128); }
            }
            float ot[8];
#pragma unroll
            for (int i = 0; i < 8; ++i) ot[i] = __shfl_xor(kf[i], 1);
            if (rot && ch < 2) { float cs[16];
#pragma unroll
                for (int i = 0; i < 4; ++i) { const f32x4v t = *(const f32x4v*)(rope + pi * 16 + 4 * i); cs[4 * i] = t.x; cs[4 * i + 1] = t.y; cs[4 * i + 2] = t.z; cs[4 * i + 3] = t.w; }
                rope8(kf, ot, cs, ch == 1); }
            { v4u kw; kw.x = pg8::cvt_pk_bf16(kf[0], kf[1]); kw.y = pg8::cvt_pk_bf16(kf[2], kf[3]); kw.z = pg8::cvt_pk_bf16(kf[4], kf[5]); kw.w = pg8::cvt_pk_bf16(kf[6], kf[7]);
              *(LAS v4u*)(kN + j * AK_STR + ch * 8) = kw;
              LAS bf16* vd = vT + (ch * 8) * AV_STR + cswz(pperm(j), ch >> 1);
#pragma unroll
              for (int i = 0; i < 8; ++i) vd[i * AV_STR] = (bf16)(pg8::cvt_pk_bf16(vf[i], 0.f) & 0xffffu); }
            int p = -1; float* ko = nullptr; float* vo = nullptr;
            if (!samp) { if (c == 31 && j >= 64) { p = j - 64; ko = a.out + O_KP; vo = a.out + O_VP; } }
            else { if (j >= 16 && j < 144) { p = j - 16; ko = a.out + O_KS; vo = a.out + O_VS; } }
            if (p >= 0) { const size_t o = (((size_t)n * 128 + p) * 4 + kvh) * 64 + ch * 8;
                *(f32x4v*)(ko + o) = (f32x4v){kf[0], kf[1], kf[2], kf[3]}; *(f32x4v*)(ko + o + 4) = (f32x4v){kf[4], kf[5], kf[6], kf[7]};
                *(f32x4v*)(vo + o) = (f32x4v){vf[0], vf[1], vf[2], vf[3]}; *(f32x4v*)(vo + o + 4) = (f32x4v){vf[4], vf[5], vf[6], vf[7]}; }
        }
        __syncthreads();
        const float sinkv = a.in[I_SINKS][head];
#pragma unroll
        for (int qh = 0; qh < 2; ++qh) { if (samp && qh == 1) break;
            const int ln = OPQ(lane), r16 = ln & 15, g4 = ln >> 4;
            bf16x8 qf[2][2];
#pragma unroll
            for (int qt = 0; qt < 2; ++qt) {
                const int ql = qh * 32 + qt * 16 + r16;
                const int qpi = samp ? 2048 + r16 : c * 64 + ql;
                const v4u w0 = qraw[qh][qt][0], w1 = qraw[qh][qt][1];
                float x[8], y[8], ot[8]; unpack8(w0, x); unpack8(w1, y);
                v4u wo; wo.x = __shfl_xor(w0.x, 16); wo.y = __shfl_xor(w0.y, 16); wo.z = __shfl_xor(w0.z, 16); wo.w = __shfl_xor(w0.w, 16); unpack8(wo, ot);
                if (g4 < 2) { float cs[16];
#pragma unroll
                    for (int i = 0; i < 4; ++i) { const f32x4v t = *(const f32x4v*)(rope + qpi * 16 + 4 * i); cs[4 * i] = t.x; cs[4 * i + 1] = t.y; cs[4 * i + 2] = t.z; cs[4 * i + 3] = t.w; }
                    rope8(x, ot, cs, g4 == 1); }
                qf[qt][0] = mk8(x[0] * 0.125f, x[1] * 0.125f, x[2] * 0.125f, x[3] * 0.125f, x[4] * 0.125f, x[5] * 0.125f, x[6] * 0.125f, x[7] * 0.125f);
                qf[qt][1] = mk8(y[0] * 0.125f, y[1] * 0.125f, y[2] * 0.125f, y[3] * 0.125f, y[4] * 0.125f, y[5] * 0.125f, y[6] * 0.125f, y[7] * 0.125f);
            }
            float mx[2] = {sinkv, sinkv}, ls[2]; ls[0] = (g4 == 0) ? 1.0f : 0.0f; ls[1] = ls[0];
            f32x4 O[4][2];
#pragma unroll
            for (int dt = 0; dt < 4; ++dt)
#pragma unroll
                for (int qt = 0; qt < 2; ++qt) O[dt][qt] = (f32x4){0.f, 0.f, 0.f, 0.f};
#pragma unroll 1
            for (int kb = kb0; kb < 3; ++kb) {
                f32x4 S[4][2];
#pragma unroll
                for (int kt = 0; kt < 4; ++kt)
#pragma unroll
                    for (int qt = 0; qt < 2; ++qt) S[kt][qt] = (f32x4){0.f, 0.f, 0.f, 0.f};
                { bf16x8 ak[2][4];
#pragma unroll
                  for (int ks = 0; ks < 2; ++ks)
#pragma unroll
                      for (int kt = 0; kt < 4; ++kt) ak[ks][kt] = *(const LAS bf16x8*)(kN + (64 * kb + 16 * kt + r16) * AK_STR + 32 * ks + 8 * g4);
#pragma unroll
                  for (int ks = 0; ks < 2; ++ks)
#pragma unroll
                      for (int kt = 0; kt < 4; ++kt)
#pragma unroll
                          for (int qt = 0; qt < 2; ++qt) S[kt][qt] = AMFMA(ak[ks][kt], qf[qt][ks], S[kt][qt]); }
                bf16x8 av[2][4];
#pragma unroll
                for (int ksk = 0; ksk < 2; ++ksk)
#pragma unroll
                    for (int dt = 0; dt < 4; ++dt) av[ksk][dt] = *(const LAS bf16x8*)(vT + (16 * dt + r16) * AV_STR + (((8 * kb + 4 * ksk + g4) ^ dt) << 3));
                if (64 * kb + 64 > nvalid) {
#pragma unroll
                    for (int kt = 0; kt < 4; ++kt)
#pragma unroll
                        for (int rr = 0; rr < 4; ++rr) if (64 * kb + 16 * kt + 4 * g4 + rr >= nvalid) { S[kt][0][rr] = -1e30f; S[kt][1][rr] = -1e30f; } }
                bf16x8 pb[2][2];
#pragma unroll
                for (int qt = 0; qt < 2; ++qt) {
                    float bm = -1e30f;
#pragma unroll
                    for (int kt = 0; kt < 4; ++kt) bm = fmaxf(fmaxf(bm, fmaxf(S[kt][qt][0], S[kt][qt][1])), fmaxf(S[kt][qt][2], S[kt][qt][3]));
                    bm = fmaxf(bm, __shfl_xor(bm, 16)); bm = fmaxf(bm, __shfl_xor(bm, 32));
                    const float mn = fmaxf(mx[qt], bm), corr = __expf(mx[qt] - mn); mx[qt] = mn;
                    float lsum = 0.f;
#pragma unroll
                    for (int kt = 0; kt < 4; ++kt)
#pragma unroll
                        for (int rr = 0; rr < 4; ++rr) { const float p = __expf(S[kt][qt][rr] - mn); S[kt][qt][rr] = p; lsum += p; }
                    ls[qt] = ls[qt] * corr + lsum;
#pragma unroll
                    for (int dt = 0; dt < 4; ++dt) O[dt][qt] = O[dt][qt] * corr;
                    pb[qt][0] = mk8(S[0][qt][0], S[0][qt][1], S[0][qt][2], S[0][qt][3], S[1][qt][0], S[1][qt][1], S[1][qt][2], S[1][qt][3]);
                    pb[qt][1] = mk8(S[2][qt][0], S[2][qt][1], S[2][qt][2], S[2][qt][3], S[3][qt][0], S[3][qt][1], S[3][qt][2], S[3][qt][3]);
                }
#pragma unroll
                for (int ksk = 0; ksk < 2; ++ksk)
#pragma unroll
                    for (int dt = 0; dt < 4; ++dt)
#pragma unroll
                        for (int qt = 0; qt < 2; ++qt) O[dt][qt] = AMFMA(av[ksk][dt], pb[qt][ksk], O[dt][qt]);
            }
#pragma unroll
            for (int qt = 0; qt < 2; ++qt) {
                float lt = ls[qt]; lt += __shfl_xor(lt, 16); lt += __shfl_xor(lt, 32);
                const float il = 1.0f / lt;
                const int ql = qh * 32 + qt * 16 + r16;
                const bool act = samp ? (qt == 0) : true;
                const size_t qr = samp ? (size_t)NP + n * NST + r16 : (size_t)n * SEQ + c * 64 + ql;
                if (act) {
#pragma unroll
                    for (int dt = 0; dt < 4; ++dt) { u32x2v o; o.x = pg8::cvt_pk_bf16(O[dt][qt][0] * il, O[dt][qt][1] * il); o.y = pg8::cvt_pk_bf16(O[dt][qt][2] * il, O[dt][qt][3] * il);
                        *(GAS u32x2v*)(mix + qr * D + head * 64 + 16 * dt + 4 * g4) = o; } }
            }
        }
    }
#undef AMFMA
    {
        const float* cw = a.in[I_SCW];
        const int cg = tid & 255, hf = tid >> 8, ch0 = cg * 8;
        float w0[8], w1[8], w2[8];
#pragma unroll
        for (int i = 0; i < 8; ++i) { w0[i] = cw[ch0 + i]; w1[i] = cw[2048 + ch0 + i]; w2[i] = cw[4096 + ch0 + i]; }
        for (int u = F.vcu; u < 512 + 16; u += F.G) {
            int T, ta, tb; size_t rowb; const float* st = nullptr; float* so;
            if (u < 512) { const int n = u >> 6, seg = u & 63; T = SEQ; rowb = (size_t)n * SEQ; ta = seg * 32 + hf * 16; tb = ta + 16; so = a.out + O_CP + (size_t)n * 2 * 2048; }
            else { const int n = u - 512; T = NST; rowb = (size_t)NP + n * NST; ta = hf * 8; tb = ta + 8; st = a.in[I_SSC] + (size_t)n * 2 * 2048; so = a.out + O_CS + (size_t)n * 2 * 2048; }
            float um2[8], um1[8];
#pragma unroll
            for (int i = 0; i < 8; ++i) { um2[i] = 0.f; um1[i] = 0.f; }
            for (int t = ta - 2; t < tb; ++t) {
                float uc[8], bg[8];
                if (t >= 0) { const bf16* r = proj + (rowb + t) * IN0 + ch0; float cgv[8], xv[8];
                    unpack8(*(const GAS v4u*)(r + C_C), cgv); unpack8(*(const GAS v4u*)(r + C_X), xv); unpack8(*(const GAS v4u*)(r + C_B), bg);
#pragma unroll
                    for (int i = 0; i < 8; ++i) uc[i] = cgv[i] * xv[i]; }
                else {
#pragma unroll
                    for (int i = 0; i < 8; ++i) { uc[i] = st ? st[(size_t)(2 + t) * 2048 + ch0 + i] : 0.f; bg[i] = 0.f; } }
                if (t >= ta) { float z[8];
#pragma unroll
                    for (int i = 0; i < 8; ++i) z[i] = bg[i] * (w0[i] * um2[i] + w1[i] * um1[i] + w2[i] * uc[i]);
                    *(GAS v4u*)(mix + (rowb + t) * D + 2048 + ch0) = pack8(z); }
                if (t >= T - 2 && t >= ta) { float* o = so + (size_t)(t - (T - 2)) * 2048 + ch0;
                    *(f32x4v*)o = (f32x4v){uc[0], uc[1], uc[2], uc[3]}; *(f32x4v*)(o + 4) = (f32x4v){uc[4], uc[5], uc[6], uc[7]}; }
#pragma unroll
                for (int i = 0; i < 8; ++i) { um2[i] = um1[i]; um1[i] = uc[i]; }
            }
        }
    }
}

constexpr int GQ_STR = 136, GT_STR = 72;
constexpr int G_QP = 0, G_KP = 17408, G_KT = 34816, G_VT = 53248, G_WP = 71680, G_AQ = 89088, G_TU = 98304, G_TW = 107520, G_AF = 116736, G_ST = 71680, G_SM = 137216;
constexpr int G_CW = 139264;
constexpr int G_OS = G_TU;
constexpr int AF_STR = 68;
#define GMFMA(A_, B_, C_) __builtin_amdgcn_mfma_f32_16x16x32_bf16((A_), (B_), (C_), 0, 0, 0)
#define LBAR() do { asm volatile("s_waitcnt lgkmcnt(0)" ::: "memory"); __builtin_amdgcn_s_barrier(); asm volatile("" ::: "memory"); } while (0)
__device__ __forceinline__ void gdn_phase(const Frame& F, const Args& a) {
    unsigned char* ws = a.ws;
    const bf16* proj = (const bf16*)(ws + WS_BIG); const float* aux = (const float*)(ws + WS_AUX); bf16* og = (bf16*)(ws + WS_MIX);
    LAS unsigned char* L = F.lds;
    LAS bf16* qP = (LAS bf16*)(L + G_QP); LAS bf16* kP = (LAS bf16*)(L + G_KP); LAS bf16* kT = (LAS bf16*)(L + G_KT); LAS bf16* vT = (LAS bf16*)(L + G_VT);
    LAS bf16* wP = (LAS bf16*)(L + G_WP); LAS bf16* aqP = (LAS bf16*)(L + G_AQ); LAS bf16* TuP = (LAS bf16*)(L + G_TU); LAS bf16* TwP = (LAS bf16*)(L + G_TW);
    LAS float* Af = (LAS float*)(L + G_AF); LAS float* os = (LAS float*)(L + G_OS); LAS float* stash = (LAS float*)(L + G_ST); LAS float* Xf = (LAS float*)(L + G_WP);
    LAS float* cwl = (LAS float*)(L + G_CW);
    LAS float* sm = (LAS float*)(L + G_SM); LAS float* ssq = sm; LAS float* Gs = sm + 128; LAS float* eGs = sm + 192; LAS float* eGls = sm + 256; LAS float* bes = sm + 320; LAS float* rqs = sm + 384; LAS float* rks = sm + 448;
    const int tid = F.tid, lane = F.lane, w = F.wave;
    const float* cw = a.in[I_DCW];
    for (int ch = F.vcu; ch < 256 + 512; ch += F.G) {
        const bool samp = ch >= 256;
        int n, h, T, TB; size_t rowb;
        if (!samp) { n = ch >> 5; h = ch & 31; T = SEQ; TB = 64; rowb = (size_t)n * SEQ; }
        else { const int v = ch - 256; n = v >> 5; h = v & 31; T = NST; TB = 16; rowb = (size_t)NP + n * NST; }
        const float Aexp = __expf(a.in[I_ALOG][h]), dtb = a.in[I_DTB][h];
        f32x4 S[8];
        { const int ln = OPQ(lane), r16 = ln & 15, g4 = ln >> 4;
        if (samp) { const float* s0 = a.in[I_SDN] + (((size_t)n * 32 + h) * 128) * 128;
#pragma unroll
            for (int dt = 0; dt < 8; ++dt)
#pragma unroll
                for (int rg_ = 0; rg_ < 4; ++rg_) S[dt][rg_] = s0[(size_t)(16 * dt + 4 * g4 + rg_) * 128 + 16 * w + r16]; }
        else {
#pragma unroll
            for (int dt = 0; dt < 8; ++dt) S[dt] = (f32x4){0.f, 0.f, 0.f, 0.f}; } }
        LBAR();
        if (tid < 384) {
#pragma unroll
            for (int i = 0; i < 4; ++i) cwl[i * 384 + tid] = cw[(size_t)i * QKV + (tid >> 7) * 4096 + h * 128 + (tid & 127)]; }
        if (tid < 128) ssq[tid] = 0.f;
        v4u P[10]; float av = 0.f, bv = 0.f;
#define GDN_PREFETCH(tn_) do { const int td_ = OPQ(tid), cg_ = td_ % 48, rg_ = td_ / 48, gch_ = (cg_ >> 4) * 4096 + h * 128 + (cg_ & 15) * 8; const int tn = (tn_); \
            if (rg_ < 10) { _Pragma("unroll") for (int r = 0; r < 10; ++r) { const int t = tn + rg_ * 7 + r - 3; \
                if (t >= 0 && t < T) P[r] = *(const GAS v4u*)(proj + (rowb + t) * IN1M + gch_); \
                else if (t < 0 && samp) { const float* sp = a.in[I_SDC] + ((size_t)n * 3 + (3 + t)) * QKV + gch_; P[r] = pack8(sp); } \
                else P[r] = (v4u){0u, 0u, 0u, 0u}; } } \
            if (w == 7) { const int ln_ = OPQ(lane); av = 0.f; bv = 0.f; if (ln_ < TB && tn + ln_ < T) { av = aux[(rowb + tn + ln_) * 64 + h]; bv = aux[(rowb + tn + ln_) * 64 + 32 + h]; } } } while (0)
        GDN_PREFETCH(0);
        for (int t0 = 0; t0 < T; t0 += 64) {
            LBAR();
            v4u gt0 = (v4u){0u, 0u, 0u, 0u}, gt1 = gt0;
            { const int td = OPQ(tid), r = td >> 3, j = td & 7;
              if (r < TB) { const bf16* gp = proj + (rowb + t0 + r) * IN1M + QKV + h * 128 + j * 16; gt0 = *(const GAS v4u*)gp; gt1 = *(const GAS v4u*)(gp + 8); } }
            { const int td = OPQ(tid), cg = td % 48, rg = td / 48, part = cg >> 4, c0 = (cg & 15) * 8, gch = part * 4096 + h * 128 + c0;
            if (rg < 10) {
                float cwv[4][8];
#pragma unroll
                for (int i = 0; i < 4; ++i) { const f32x4v c0v = *(const LAS f32x4v*)(cwl + i * 384 + part * 128 + c0), c1v = *(const LAS f32x4v*)(cwl + i * 384 + part * 128 + c0 + 4);
                    cwv[i][0] = c0v.x; cwv[i][1] = c0v.y; cwv[i][2] = c0v.z; cwv[i][3] = c0v.w; cwv[i][4] = c1v.x; cwv[i][5] = c1v.y; cwv[i][6] = c1v.z; cwv[i][7] = c1v.w; }
                float w0[8], w1[8], w2[8]; unpack8(P[0], w0); unpack8(P[1], w1); unpack8(P[2], w2);
#pragma unroll
                for (int r = 3; r < 10; ++r) { const int t = t0 + rg * 7 + r - 3, lr = rg * 7 + r - 3;
                    float cur[8]; unpack8(P[r], cur);
                    if (t >= T - 3 && t < T) { float* o = a.out + (samp ? O_DCS : O_DCP) + ((size_t)n * 3 + (t - (T - 3))) * QKV + gch;
                        *(f32x4v*)o = (f32x4v){cur[0], cur[1], cur[2], cur[3]}; *(f32x4v*)(o + 4) = (f32x4v){cur[4], cur[5], cur[6], cur[7]}; }
                    float ss = 0.f; const float lf = (lr < TB) ? 1.0f : 0.0f; float yv[8];
#pragma unroll
                    for (int k = 0; k < 8; ++k) { const float x = __builtin_fmaf(cwv[3][k], cur[k], __builtin_fmaf(cwv[2][k], w2[k], __builtin_fmaf(cwv[1][k], w1[k], cwv[0][k] * w0[k])));
                        const float yy = x * __builtin_amdgcn_rcpf(1.0f + __expf(-x)) * lf; yv[k] = yy; ss = __builtin_fmaf(yy, yy, ss); }
                    float ssr = ss; ssr += __shfl_xor(ssr, 1); ssr += __shfl_xor(ssr, 2); ssr += __shfl_xor(ssr, 4); ssr += __shfl_xor(ssr, 8);
                    if (lr < 64) {
                        u32x2v lo, hi; lo.x = pg8::cvt_pk_bf16(yv[0], yv[1]); lo.y = pg8::cvt_pk_bf16(yv[2], yv[3]); hi.x = pg8::cvt_pk_bf16(yv[4], yv[5]); hi.y = pg8::cvt_pk_bf16(yv[6], yv[7]);
                        if (part < 2) { LAS bf16* d = (part == 0 ? qP : kP) + lr * GQ_STR + pperm(c0); *(LAS u32x2v*)d = lo; *(LAS u32x2v*)(d + 8) = hi;
                            if ((cg & 15) == 0) ssq[lr * 2 + part] = ssr; }
                        if (part >= 1) { LAS bf16* d = (part == 1 ? kT : vT) + c0 * GT_STR + cswz(pperm(lr), c0 >> 4);
                            d[0 * GT_STR] = (bf16)(lo.x & 0xffffu); d[1 * GT_STR] = (bf16)(lo.x >> 16); d[2 * GT_STR] = (bf16)(lo.y & 0xffffu); d[3 * GT_STR] = (bf16)(lo.y >> 16);
                            d[4 * GT_STR] = (bf16)(hi.x & 0xffffu); d[5 * GT_STR] = (bf16)(hi.x >> 16); d[6 * GT_STR] = (bf16)(hi.y & 0xffffu); d[7 * GT_STR] = (bf16)(hi.y >> 16); }
                    }
#pragma unroll
                    for (int k = 0; k < 8; ++k) { w0[k] = w1[k]; w1[k] = w2[k]; w2[k] = cur[k]; }
                    __builtin_amdgcn_sched_barrier(0);
                }
            } }
            if (w == 7) { float gv = 0.f, be = 0.f;
                if (lane < TB) { const float x = av + dtb; const float sp = fmaxf(x, 0.f) + log1pf(__expf(-fabsf(x)));
                    gv = -Aexp * sp; be = 1.0f / (1.0f + __expf(-bv)); }
                float Gc = gv;
#pragma unroll
                for (int o = 1; o < 64; o <<= 1) { const float t = __shfl_up(Gc, o); if (lane >= o) Gc += t; }
                const float G63 = __shfl(Gc, 63);
                Gs[lane] = Gc; eGs[lane] = __expf(Gc); eGls[lane] = __expf(G63 - Gc); bes[lane] = be; }
            if (t0 + 64 < T) GDN_PREFETCH(t0 + 64);
            LBAR();
            {
                const int ln = OPQ(lane), r16 = ln & 15, g4 = ln >> 4;
                const int ti = w >> 1, tj0 = 2 * (w & 1);
                if (tid < 64) { rqs[tid] = rsqrtf(ssq[2 * tid] + RMS6) * 0.08838834764831845f; rks[tid] = rsqrtf(ssq[2 * tid + 1] + RMS6); }
                f32x4 kk[2], qk[2];
#pragma unroll
                for (int c = 0; c < 2; ++c) { kk[c] = (f32x4){0.f, 0.f, 0.f, 0.f}; qk[c] = (f32x4){0.f, 0.f, 0.f, 0.f}; }
#pragma unroll
                for (int ks = 0; ks < 4; ++ks) {
                    const bf16x8 ak = *(const LAS bf16x8*)(kP + (16 * ti + r16) * GQ_STR + 32 * ks + 8 * g4), aq = *(const LAS bf16x8*)(qP + (16 * ti + r16) * GQ_STR + 32 * ks + 8 * g4);
#pragma unroll
                    for (int c = 0; c < 2; ++c) { const bf16x8 bk = *(const LAS bf16x8*)(kP + (16 * (tj0 + c) + r16) * GQ_STR + 32 * ks + 8 * g4);
                        kk[c] = GMFMA(ak, bk, kk[c]); qk[c] = GMFMA(aq, bk, qk[c]); }
                }
#pragma unroll
                for (int c = 0; c < 2; ++c) { const int tj = 16 * (tj0 + c) + r16; const float Gj = Gs[tj]; const int ptj = pperm(tj); const float rkj = rsqrtf(ssq[2 * tj + 1] + RMS6);
#pragma unroll
                    for (int rr = 0; rr < 4; ++rr) { const int tr = 16 * ti + 4 * g4 + rr; const float Gi = Gs[tr];
                        const float rqi = rsqrtf(ssq[2 * tr] + RMS6) * 0.08838834764831845f, rki = rsqrtf(ssq[2 * tr + 1] + RMS6);
                        const float dec = (tr >= tj) ? __expf(Gi - Gj) * rkj : 0.f;
                        Af[tr * AF_STR + tj] = (tr > tj) ? bes[tr] * rki * kk[c][rr] * dec : 0.f;
                        aqP[tr * GT_STR + ptj] = (bf16)(pg8::cvt_pk_bf16(rqi * qk[c][rr] * dec, 0.f) & 0xffffu); }
                }
            }
            LBAR();
            if (w < 4) {
                const int ln = OPQ(lane), c = ln & 15;
                float Ar[16], Tr[16];
#pragma unroll
                for (int i = 0; i < 16; ++i) Ar[i] = Af[(16 * w + i) * AF_STR + 16 * w + c];
                Tr[0] = (c == 0) ? 1.0f : 0.0f;
#pragma unroll
                for (int i = 1; i < 16; ++i) {
                    float acc0 = 0.f, acc1 = 0.f;
#pragma unroll
                    for (int j = 0; j < i; ++j) { const float sv = __builtin_bit_cast(float, __builtin_amdgcn_readlane(__builtin_bit_cast(int, Ar[i]), j));
                        if (j & 1) acc1 += sv * Tr[j]; else acc0 += sv * Tr[j]; }
                    Tr[i] = (c == i) ? 1.0f : -(acc0 + acc1);
                }
                if (ln < 16) {
#pragma unroll
                    for (int i = 0; i < 16; ++i) Xf[(16 * w + i) * AF_STR + 16 * w + c] = Tr[i]; }
            } else {
                const int t2 = OPQ(tid) - 256, zr = t2 >> 4, zc = t2 & 15;
                Xf[(0 + zr) * AF_STR + 16 + zc] = 0.f; Xf[(0 + zr) * AF_STR + 32 + zc] = 0.f; Xf[(0 + zr) * AF_STR + 48 + zc] = 0.f;
                Xf[(16 + zr) * AF_STR + 32 + zc] = 0.f; Xf[(16 + zr) * AF_STR + 48 + zc] = 0.f; Xf[(32 + zr) * AF_STR + 48 + zc] = 0.f;
            }
            LBAR();
#define INV_TASK(bi_, bb_, nterms_) do { const int ln = OPQ(lane), r = ln & 15, g = ln >> 4; const int bi = (bi_), bb = (bb_); \
                f32x4 Pm = (f32x4){0.f, 0.f, 0.f, 0.f}; \
                _Pragma("unroll") for (int jt = 0; jt < (nterms_); ++jt) { const int bj = bb + jt; \
                    const f32x4v a4 = *(const LAS f32x4v*)(Af + (16 * bi + r) * AF_STR + 16 * bj + 4 * g); \
                    const LAS float* bp = Xf + (16 * bj + 4 * g) * AF_STR + 16 * bb + r; \
                    const float b0 = bp[0], b1 = bp[AF_STR], b2 = bp[2 * AF_STR], b3 = bp[3 * AF_STR]; \
                    Pm = __builtin_amdgcn_mfma_f32_16x16x4f32(a4.x, b0, Pm, 0, 0, 0); Pm = __builtin_amdgcn_mfma_f32_16x16x4f32(a4.y, b1, Pm, 0, 0, 0); \
                    Pm = __builtin_amdgcn_mfma_f32_16x16x4f32(a4.z, b2, Pm, 0, 0, 0); Pm = __builtin_amdgcn_mfma_f32_16x16x4f32(a4.w, b3, Pm, 0, 0, 0); } \
                const f32x4v x4 = *(const LAS f32x4v*)(Xf + (16 * bi + r) * AF_STR + 16 * bi + 4 * g); \
                f32x4 Xm = (f32x4){0.f, 0.f, 0.f, 0.f}; \
                Xm = __builtin_amdgcn_mfma_f32_16x16x4f32(x4.x, Pm[0], Xm, 0, 0, 0); Xm = __builtin_amdgcn_mfma_f32_16x16x4f32(x4.y, Pm[1], Xm, 0, 0, 0); \
                Xm = __builtin_amdgcn_mfma_f32_16x16x4f32(x4.z, Pm[2], Xm, 0, 0, 0); Xm = __builtin_amdgcn_mfma_f32_16x16x4f32(x4.w, Pm[3], Xm, 0, 0, 0); \
                LAS float* xo = Xf + (16 * bi + 4 * g) * AF_STR + 16 * bb + r; \
                xo[0] = -Xm[0]; xo[AF_STR] = -Xm[1]; xo[2 * AF_STR] = -Xm[2]; xo[3 * AF_STR] = -Xm[3]; } while (0)
            if (w == 0) { INV_TASK(1, 0, 1); asm volatile("s_waitcnt lgkmcnt(0)" ::: "memory"); INV_TASK(2, 0, 2); asm volatile("s_waitcnt lgkmcnt(0)" ::: "memory"); INV_TASK(3, 0, 3); }
            else if (w == 1) { INV_TASK(2, 1, 1); asm volatile("s_waitcnt lgkmcnt(0)" ::: "memory"); INV_TASK(3, 1, 2); }
            else if (w == 2) { INV_TASK(3, 2, 1); }
            LBAR();
#undef INV_TASK
            { const int td = OPQ(tid), row = td >> 3, c0 = (td & 7) * 8;
              const f32x4v x0 = *(const LAS f32x4v*)(Xf + row * AF_STR + c0), x1 = *(const LAS f32x4v*)(Xf + row * AF_STR + c0 + 4);
              const f32x4v be0 = *(const LAS f32x4v*)(bes + c0), be1 = *(const LAS f32x4v*)(bes + c0 + 4), eg0 = *(const LAS f32x4v*)(eGs + c0), eg1 = *(const LAS f32x4v*)(eGs + c0 + 4);
              const f32x4v rk0 = *(const LAS f32x4v*)(rks + c0), rk1 = *(const LAS f32x4v*)(rks + c0 + 4);
              const f32x4v u0 = x0 * be0, u1 = x1 * be1, w0 = u0 * eg0 * rk0, w1 = u1 * eg1 * rk1;
              u32x2v lo, hi; const int pc = pperm(c0);
              lo.x = pg8::cvt_pk_bf16(u0.x, u0.y); lo.y = pg8::cvt_pk_bf16(u0.z, u0.w); hi.x = pg8::cvt_pk_bf16(u1.x, u1.y); hi.y = pg8::cvt_pk_bf16(u1.z, u1.w);
              *(LAS u32x2v*)(TuP + row * GT_STR + pc) = lo; *(LAS u32x2v*)(TuP + row * GT_STR + pc + 8) = hi;
              lo.x = pg8::cvt_pk_bf16(w0.x, w0.y); lo.y = pg8::cvt_pk_bf16(w0.z, w0.w); hi.x = pg8::cvt_pk_bf16(w1.x, w1.y); hi.y = pg8::cvt_pk_bf16(w1.z, w1.w);
              *(LAS u32x2v*)(TwP + row * GT_STR + pc) = lo; *(LAS u32x2v*)(TwP + row * GT_STR + pc + 8) = hi; }
            LBAR();
            f32x4 ub[4];
            {
                const int ln = OPQ(lane), r16 = ln & 15, g4 = ln >> 4;
                f32x4 wt[4];
#pragma unroll
                for (int tt = 0; tt < 4; ++tt) { ub[tt] = (f32x4){0.f, 0.f, 0.f, 0.f}; wt[tt] = (f32x4){0.f, 0.f, 0.f, 0.f}; }
#pragma unroll
                for (int ks = 0; ks < 2; ++ks) {
                    const bf16x8 bv = *(const LAS bf16x8*)(vT + (16 * w + r16) * GT_STR + (((4 * ks + g4) ^ w) << 3)), ak = *(const LAS bf16x8*)(kT + (16 * w + r16) * GT_STR + (((4 * ks + g4) ^ w) << 3));
#pragma unroll
                    for (int tt = 0; tt < 4; ++tt) { const bf16x8 at = *(const LAS bf16x8*)(TuP + (16 * tt + r16) * GT_STR + 32 * ks + 8 * g4), bt = *(const LAS bf16x8*)(TwP + (16 * tt + r16) * GT_STR + 32 * ks + 8 * g4);
                        ub[tt] = GMFMA(at, bv, ub[tt]); wt[tt] = GMFMA(ak, bt, wt[tt]); }
                }
                const int pd = pperm(16 * w + 4 * g4);
#pragma unroll
                for (int tt = 0; tt < 4; ++tt) { u32x2v o; o.x = pg8::cvt_pk_bf16(-wt[tt][0], -wt[tt][1]); o.y = pg8::cvt_pk_bf16(-wt[tt][2], -wt[tt][3]); *(LAS u32x2v*)(wP + (16 * tt + r16) * GQ_STR + pd) = o; }
            }
            LBAR();
            {
                const int ln = OPQ(lane), r16 = ln & 15, g4 = ln >> 4;
                bf16x8 Sb[4];
#pragma unroll
                for (int ks = 0; ks < 4; ++ks) Sb[ks] = mk8(S[2 * ks][0], S[2 * ks][1], S[2 * ks][2], S[2 * ks][3], S[2 * ks + 1][0], S[2 * ks + 1][1], S[2 * ks + 1][2], S[2 * ks + 1][3]);
                f32x4 u[4], o[4];
#pragma unroll
                for (int tt = 0; tt < 4; ++tt) { u[tt] = ub[tt]; o[tt] = (f32x4){0.f, 0.f, 0.f, 0.f}; }
#pragma unroll
                for (int ks = 0; ks < 4; ++ks)
#pragma unroll
                    for (int tt = 0; tt < 4; ++tt) { const bf16x8 aw = *(const LAS bf16x8*)(wP + (16 * tt + r16) * GQ_STR + 32 * ks + 8 * g4), aq = *(const LAS bf16x8*)(qP + (16 * tt + r16) * GQ_STR + 32 * ks + 8 * g4);
                        u[tt] = GMFMA(aw, Sb[ks], u[tt]); o[tt] = GMFMA(aq, Sb[ks], o[tt]); }
#pragma unroll
                for (int tt = 0; tt < 4; ++tt)
#pragma unroll
                    for (int rr = 0; rr < 4; ++rr) o[tt][rr] *= eGs[16 * tt + 4 * g4 + rr] * rqs[16 * tt + 4 * g4 + rr];
                bf16x8 Ub[2], Us[2];
#pragma unroll
                for (int ks = 0; ks < 2; ++ks) {
                    Ub[ks] = mk8(u[2 * ks][0], u[2 * ks][1], u[2 * ks][2], u[2 * ks][3], u[2 * ks + 1][0], u[2 * ks + 1][1], u[2 * ks + 1][2], u[2 * ks + 1][3]);
                    float e[8];
#pragma unroll
                    for (int rr = 0; rr < 4; ++rr) { e[rr] = u[2 * ks][rr] * (eGls[32 * ks + 4 * g4 + rr] * rks[32 * ks + 4 * g4 + rr]); e[4 + rr] = u[2 * ks + 1][rr] * (eGls[32 * ks + 16 + 4 * g4 + rr] * rks[32 * ks + 16 + 4 * g4 + rr]); }
                    Us[ks] = mk8(e[0], e[1], e[2], e[3], e[4], e[5], e[6], e[7]);
                }
#pragma unroll
                for (int ks = 0; ks < 2; ++ks)
#pragma unroll
                    for (int tt = 0; tt < 4; ++tt) { const bf16x8 aa = *(const LAS bf16x8*)(aqP + (16 * tt + r16) * GT_STR + 32 * ks + 8 * g4); o[tt] = GMFMA(aa, Ub[ks], o[tt]); }
                const float cd = eGs[63];
#pragma unroll
                for (int dt = 0; dt < 8; ++dt) { S[dt] = S[dt] * cd;
#pragma unroll
                    for (int ks = 0; ks < 2; ++ks) { const bf16x8 ak = *(const LAS bf16x8*)(kT + (16 * dt + r16) * GT_STR + (((4 * ks + g4) ^ dt) << 3)); S[dt] = GMFMA(ak, Us[ks], S[dt]); } }
#pragma unroll
                for (int tt = 0; tt < 4; ++tt)
#pragma unroll
                    for (int rr = 0; rr < 4; ++rr) os[(16 * tt + 4 * g4 + rr) * 128 + 16 * w + r16] = o[tt][rr];
            }
            LBAR();
            { const int td = OPQ(tid), r = td >> 3, j = td & 7;
              if (r < TB) { float ov[16]; float ss = 0.f;
#pragma unroll
                for (int i = 0; i < 4; ++i) { const f32x4v t4 = *(const LAS f32x4v*)(os + r * 128 + j * 16 + 4 * i); ov[4 * i] = t4.x; ov[4 * i + 1] = t4.y; ov[4 * i + 2] = t4.z; ov[4 * i + 3] = t4.w; ss += (t4.x * t4.x + t4.y * t4.y) + (t4.z * t4.z + t4.w * t4.w); }
                ss += __shfl_xor(ss, 1); ss += __shfl_xor(ss, 2); ss += __shfl_xor(ss, 4);
                const float rs = rsqrtf(ss * (1.0f / 128.0f) + RMS6);
                const size_t row = rowb + t0 + r; float gt[16];
                unpack8(gt0, gt); unpack8(gt1, gt + 8);
                const float* onw = a.in[I_ONW] + j * 16;
#pragma unroll
                for (int i = 0; i < 16; ++i) ov[i] = ov[i] * rs * onw[i] * siluf(gt[i]);
                *(GAS v4u*)(og + row * D + h * 128 + j * 16) = pack8(ov); *(GAS v4u*)(og + row * D + h * 128 + j * 16 + 8) = pack8(ov + 8); }
            }
        }
        { const int ln = OPQ(lane), r16 = ln & 15, g4 = ln >> 4; float* so = a.out + (samp ? O_DSS : O_DSP) + (((size_t)n * 32 + h) * 128) * 128;
#pragma unroll
          for (int dt = 0; dt < 8; ++dt)
#pragma unroll
              for (int rr = 0; rr < 4; ++rr) so[(size_t)(16 * dt + 4 * g4 + rr) * 128 + 16 * w + r16] = S[dt][rr]; }
    }
}
#undef GMFMA
#undef LBAR
#undef GDN_PREFETCH

__device__ __forceinline__ void final_phase(const Frame& F, const Args& a) {
    const float* ssq = (const float*)(a.ws + WS_SSQ) + 4 * (size_t)M; const float* g = a.in[I_FNORM];
    const int gw = F.vcu * NWAVES + F.wave, NGW = F.G * NWAVES;
    for (int m = gw; m < M; m += NGW) {
        float* yr = a.out + O_Y + (size_t)m * D; const float rs = rsqrtf(ssq[m] * (1.0f / D) + RMS6);
#pragma unroll
        for (int j = 0; j < 16; ++j) { const int c = j * 256 + F.lane * 4; f32x4v v = *(const f32x4v*)(yr + c); const f32x4v gg = *(const f32x4v*)(g + c);
            v.x = v.x * rs * gg.x; v.y = v.y * rs * gg.y; v.z = v.z * rs * gg.z; v.w = v.w * rs * gg.w; __builtin_nontemporal_store(v, (f32x4v*)(yr + c)); }
    }
}

__device__ __forceinline__ void ssq_reduce(const Frame& F, const float* part, float* ssq) {
    for (int b = F.vcu; b < NP / 64; b += F.G) { const int row = 64 * b + (F.tid >> 3), j = F.tid & 7;
        const f32x4v p0 = *(const f32x4v*)(part + (size_t)row * 64 + 8 * j), p1 = *(const f32x4v*)(part + (size_t)row * 64 + 8 * j + 4);
        float s = ((p0.x + p0.y) + (p0.z + p0.w)) + ((p1.x + p1.y) + (p1.z + p1.w));
        s += __shfl_xor(s, 1); s += __shfl_xor(s, 2); s += __shfl_xor(s, 4);
        if (j == 0) ssq[row] = s; }
}
__device__ __forceinline__ void sample_finalize(const Frame& F, const float* slab, int nsplit, const float* base_f, const bf16* base_b, float* out_f, bf16* out_b, float* ssq) {
    LAS float* red = (LAS float*)(F.lds + SMALL_OFF);
    for (int r = F.vcu; r < 256; r += F.G) {
        const int c0 = F.tid * 8, pn = c0 >> 8, cc = c0 & 255;
        f32x4v a0, a1;
        if (base_f) { a0 = *(const f32x4v*)(base_f + (size_t)r * D + c0); a1 = *(const f32x4v*)(base_f + (size_t)r * D + c0 + 4); }
        else { float t[8]; unpack8(*(const GAS v4u*)(base_b + (size_t)r * D + c0), t); a0 = (f32x4v){t[0], t[1], t[2], t[3]}; a1 = (f32x4v){t[4], t[5], t[6], t[7]}; }
        for (int ks = 0; ks < nsplit; ++ks) { const float* sp = slab + ((size_t)(pn * nsplit + ks) * 256 + r) * 256 + cc; a0 = a0 + *(const f32x4v*)sp; a1 = a1 + *(const f32x4v*)(sp + 4); }
        if (out_f) { *(f32x4v*)(out_f + (size_t)r * D + c0) = a0; *(f32x4v*)(out_f + (size_t)r * D + c0 + 4) = a1; }
        if (out_b) { v4u o; o.x = pk2(a0.x, a0.y); o.y = pk2(a0.z, a0.w); o.z = pk2(a1.x, a1.y); o.w = pk2(a1.z, a1.w); *(GAS v4u*)(out_b + (size_t)r * D + c0) = o; }
        float s = (a0.x * a0.x + a0.y * a0.y) + (a0.z * a0.z + a0.w * a0.w) + (a1.x * a1.x + a1.y * a1.y) + (a1.z * a1.z + a1.w * a1.w);
        s = wave_sum(s);
        __syncthreads();
        if (F.lane == 0) red[F.wave] = s;
        __syncthreads();
        if (F.tid == 0) { float t = 0.f;
#pragma unroll
            for (int i = 0; i < NWAVES; ++i) t += red[i];
            ssq[r] = t; }
    }
}
__device__ __forceinline__ void sample_finalize_up(const Frame& F, const float* slab, const float* ssq, bf16* hid) {
    for (int r = F.vcu; r < 256; r += F.G) {
        const float rs = rsqrtf(ssq[r] * (1.0f / D) + RMS6);
#pragma unroll
        for (int it = 0; it < 4; ++it) { const int c0 = (it * 512 + F.tid) * 8, pn = c0 >> 8, cc = c0 & 255;
            f32x4v a0 = (f32x4v){0.f, 0.f, 0.f, 0.f}, a1 = a0;
#pragma unroll
            for (int ks = 0; ks < 4; ++ks) { const float* sp = slab + ((size_t)(pn * 4 + ks) * 256 + r) * 256 + cc; a0 = a0 + *(const f32x4v*)sp; a1 = a1 + *(const f32x4v*)(sp + 4); }
            float z[8] = {a0.x, a0.y, a0.z, a0.w, a1.x, a1.y, a1.z, a1.w};
#pragma unroll
            for (int i = 0; i < 8; ++i) { const float t = fmaxf(z[i] * rs, 0.f); z[i] = t * t; }
            *(GAS v4u*)(hid + (size_t)r * DFF + c0) = pack8(z); }
    }
}

__device__ __forceinline__ int claim_unit(const Frame& F, unsigned* ctr) {
    volatile LAS unsigned* MISC = (volatile LAS unsigned*)(F.lds + MISC_OFF);
    if (F.tid == 0) MISC[24] = __hip_atomic_fetch_add(ctr, 1u, __ATOMIC_RELAXED, __HIP_MEMORY_SCOPE_AGENT);
    __syncthreads(); const unsigned j = MISC[24]; __syncthreads();
    return __builtin_amdgcn_readfirstlane((int)j);
}
__global__ void __launch_bounds__(NWAVES * 64, 2) mk_fwd(Args args) {
    extern __shared__ __attribute__((aligned(16))) unsigned char lds[];
    Frame F;
    F.lds = (LAS unsigned char*)lds;
    volatile LAS unsigned* MISC = (volatile LAS unsigned*)(F.lds + MISC_OFF);
    F.tid = threadIdx.x; F.lane = F.tid & 63; F.wave = __builtin_amdgcn_readfirstlane(F.tid >> 6);
    F.G = gridDim.x; { const int bx = blockIdx.x; F.vcu = (F.G % 8 == 0) ? (bx % 8) * (F.G / 8) + bx / 8 : bx; }
    unsigned char* ws = args.ws;
    if (F.tid < 64) MISC[F.tid] = 0u;
    __syncthreads();
    XcdBarrier bar; bar.bar = (unsigned*)(ws + WS_CTL) + CW_BAR; bar.x = 0; bar.st = nullptr;
    if (MK_N_LAUNCHES == 1) bar = xcd_barrier_post((unsigned*)(ws + WS_CTL) + CW_BAR, MISC + 8);
    const int lo = args.ph_lo, hi = args.ph_hi;
#define IN(k) (lo <= (k) && (k) < hi)
#define SEAM(k) do { if (IN(k) && IN((k) + 1)) xcd_barrier(bar); } while (0)
#define xcd_barrier_always(b, lo_, hi_, k_) xcd_barrier(b)
    float* ssqb = (float*)(ws + WS_SSQ); float* slab = (float*)(ws + WS_SLAB); float* ssqp = (float*)(ws + WS_SSQP);
    bf16* xb = (bf16*)(ws + WS_XB); bf16* mixb = (bf16*)(ws + WS_MIX); bf16* big = (bf16*)(ws + WS_BIG);

    if (IN(0)) { p0_prologue(F, args); } SEAM(0);
    if (IN(1)) {
        const bool split_roles = (F.G == 256);
        if (!split_roles || (int)blockIdx.x < 224) {
            pg8::Gemm g{xb, (const bf16*)(ws + WS_WINA), M, IN0, D, D}; pg8::StaticOrder S; S.init(M, IN0, split_roles ? 224 : F.G, (int)blockIdx.x);
            pg8::EpiRow<0> E{big, IN0, ssqb, nullptr, -1};
            pg8::gemm_phase<pg8::EpiRow<0>, pg8::StaticOrder, true, true>(F.lds, g, S, E);
        }
        for (;;) { const int q = claim_unit(F, (unsigned*)(ws + WS_CTL) + CW_CLAIM + 7) + CW_P0; if (q >= CW_END) break; conv_chunk(F, args, q); }
    } SEAM(1);
    if (IN(2)) { attn_phase(F, args); } SEAM(2);
    if (IN(3)) {
        { pg8::Gemm g{mixb, (const bf16*)(ws + WS_WOUTA), NP, D, 4096, 4096}; pg8::StaticOrder S; S.init(NP, D, F.G, (int)blockIdx.x);
          pg8::EpiRes<false, false> E{xb, xb, ssqp};
          pg8::gemm_phase<pg8::EpiRes<false, false>, pg8::StaticOrder, true, true>(F.lds, g, S, E); }
        { pg8::Gemm g{mixb + (size_t)NP * 4096, (const bf16*)(ws + WS_WOUTA), 256, D, 256, 4096}; pg8::EpiSlab E{slab, 16};
          for (;;) { const int j = claim_unit(F, (unsigned*)(ws + WS_CTL) + CW_CLAIM + 0); if (j >= (D / 256) * 16) break;
              pg8::SplitOrder S{D / 256, 16, 1 << 24, j};
              pg8::gemm_phase<pg8::EpiSlab, pg8::SplitOrder, true, true>(F.lds, g, S, E); } }
        xcd_barrier_always(bar, lo, hi, 3);
        ssq_reduce(F, ssqp, ssqb + 1 * (size_t)M);
        sample_finalize(F, slab, 16, nullptr, xb + (size_t)NP * D, nullptr, xb + (size_t)NP * D, ssqb + 1 * (size_t)M + NP);
    } SEAM(3);
    if (IN(4)) {
        { pg8::Gemm g{xb, (const bf16*)(ws + WS_WUP), NP, DFF, D, D}; pg8::StaticOrder S; S.init(NP, DFF, F.G, (int)blockIdx.x);
          pg8::EpiRow<1> E{big, DFF, ssqb + 1 * (size_t)M, nullptr, -1};
          pg8::gemm_phase<pg8::EpiRow<1>, pg8::StaticOrder, true, true>(F.lds, g, S, E); }
        { pg8::Gemm g{xb + (size_t)NP * D, (const bf16*)(ws + WS_WUP), 256, DFF, 1024, D}; pg8::EpiSlab E{slab, 4};
          for (;;) { const int j = claim_unit(F, (unsigned*)(ws + WS_CTL) + CW_CLAIM + 1); if (j >= (DFF / 256) * 4) break;
              pg8::SplitOrder S{DFF / 256, 4, 1 << 24, j};
              pg8::gemm_phase<pg8::EpiSlab, pg8::SplitOrder, true, true>(F.lds, g, S, E); } }
        xcd_barrier(bar);
        sample_finalize_up(F, slab, ssqb + 1 * (size_t)M + NP, big + (size_t)NP * DFF);
    } SEAM(4);
    if (IN(5)) {
        { pg8::Gemm g{big, (const bf16*)(ws + WS_WDN), NP, D, 16384, 16384}; pg8::StaticOrder S; S.init(NP, D, F.G, (int)blockIdx.x);
          pg8::EpiRes<false, false> E{xb, xb, ssqp};
          pg8::gemm_phase<pg8::EpiRes<false, false>, pg8::StaticOrder, true, true>(F.lds, g, S, E); }
        { pg8::Gemm g{big + (size_t)NP * 16384, (const bf16*)(ws + WS_WDN), 256, D, 1024, 16384}; pg8::EpiSlab E{slab, 16};
          for (;;) { const int j = claim_unit(F, (unsigned*)(ws + WS_CTL) + CW_CLAIM + 2); if (j >= (D / 256) * 16) break;
              pg8::SplitOrder S{D / 256, 16, 1 << 24, j};
              pg8::gemm_phase<pg8::EpiSlab, pg8::SplitOrder, true, true>(F.lds, g, S, E); } }
        xcd_barrier_always(bar, lo, hi, 5);
        ssq_reduce(F, ssqp, ssqb + 2 * (size_t)M);
        sample_finalize(F, slab, 16, nullptr, xb + (size_t)NP * D, nullptr, xb + (size_t)NP * D, ssqb + 2 * (size_t)M + NP);
    } SEAM(5);
    if (IN(6)) {
        pg8::Gemm g{xb, (const bf16*)(ws + WS_WING), M, IN1P, D, D}; pg8::StaticOrder S; S.init(M, IN1P, F.G, (int)blockIdx.x);
        pg8::EpiRow<0> E{big, IN1M, ssqb + 2 * (size_t)M, (float*)(ws + WS_AUX), 64};
        pg8::gemm_phase<pg8::EpiRow<0>, pg8::StaticOrder, true, true>(F.lds, g, S, E);
        if (F.G == 256 && (int)blockIdx.x >= DEF_WG6) p0_deferred(F, args, 6, (int)blockIdx.x - DEF_WG6);
    } SEAM(6);
    if (IN(7)) { gdn_phase(F, args); } SEAM(7);
    if (IN(8)) {
        { pg8::Gemm g{mixb, (const bf16*)(ws + WS_WOUTG), NP, D, 4096, 4096}; pg8::StaticOrder S; S.init(NP, D, F.G, (int)blockIdx.x);
          pg8::EpiRes<false, false> E{xb, xb, ssqp};
          pg8::gemm_phase<pg8::EpiRes<false, false>, pg8::StaticOrder, true, true>(F.lds, g, S, E); }
        { pg8::Gemm g{mixb + (size_t)NP * 4096, (const bf16*)(ws + WS_WOUTG), 256, D, 256, 4096}; pg8::EpiSlab E{slab, 16};
          for (;;) { const int j = claim_unit(F, (unsigned*)(ws + WS_CTL) + CW_CLAIM + 3); if (j >= (D / 256) * 16) break;
              pg8::SplitOrder S{D / 256, 16, 1 << 24, j};
              pg8::gemm_phase<pg8::EpiSlab, pg8::SplitOrder, true, true>(F.lds, g, S, E); } }
        xcd_barrier_always(bar, lo, hi, 8);
        ssq_reduce(F, ssqp, ssqb + 3 * (size_t)M);
        sample_finalize(F, slab, 16, nullptr, xb + (size_t)NP * D, nullptr, xb + (size_t)NP * D, ssqb + 3 * (size_t)M + NP);
    } SEAM(8);
    if (IN(9)) {
        { pg8::Gemm g{xb, (const bf16*)(ws + WS_WUP) + (size_t)DFF * D, NP, DFF, D, D}; pg8::StaticOrder S; S.init(NP, DFF, F.G, (int)blockIdx.x);
          pg8::EpiRow<1> E{big, DFF, ssqb + 3 * (size_t)M, nullptr, -1};
          pg8::gemm_phase<pg8::EpiRow<1>, pg8::StaticOrder, true, true>(F.lds, g, S, E); }
        { pg8::Gemm g{xb + (size_t)NP * D, (const bf16*)(ws + WS_WUP) + (size_t)DFF * D, 256, DFF, 1024, D}; pg8::EpiSlab E{slab, 4};
          for (;;) { const int j = claim_unit(F, (unsigned*)(ws + WS_CTL) + CW_CLAIM + 4); if (j >= (DFF / 256) * 4) break;
              pg8::SplitOrder S{DFF / 256, 4, 1 << 24, j};
              pg8::gemm_phase<pg8::EpiSlab, pg8::SplitOrder, true, true>(F.lds, g, S, E); } }
        xcd_barrier(bar);
        sample_finalize_up(F, slab, ssqb + 3 * (size_t)M + NP, big + (size_t)NP * DFF);
    } SEAM(9);
    if (IN(10)) {
        { pg8::Gemm g{big, (const bf16*)(ws + WS_WDN) + (size_t)D * DFF, NP, D, 16384, 16384}; pg8::StaticOrder S; S.init(NP, D, F.G, (int)blockIdx.x);
          pg8::EpiRes<false, true> E{xb, (args.out + O_Y), ssqp};
          pg8::gemm_phase<pg8::EpiRes<false, true>, pg8::StaticOrder, true, true>(F.lds, g, S, E); }
        { pg8::Gemm g{big + (size_t)NP * 16384, (const bf16*)(ws + WS_WDN) + (size_t)D * DFF, 256, D, 1024, 16384}; pg8::EpiSlab E{slab, 16};
          for (;;) { const int j = claim_unit(F, (unsigned*)(ws + WS_CTL) + CW_CLAIM + 5); if (j >= (D / 256) * 16) break;
              pg8::SplitOrder S{D / 256, 16, 1 << 24, j};
              pg8::gemm_phase<pg8::EpiSlab, pg8::SplitOrder, true, true>(F.lds, g, S, E); } }
        xcd_barrier_always(bar, lo, hi, 10);
        ssq_reduce(F, ssqp, ssqb + 4 * (size_t)M);
        sample_finalize(F, slab, 16, nullptr, xb + (size_t)NP * D, (args.out + O_Y) + (size_t)NP * D, nullptr, ssqb + 4 * (size_t)M + NP);
    } SEAM(10);
    if (IN(11)) { final_phase(F, args); }
#undef IN
#undef SEAM
}

extern "C" void kernel_launch(void* const* d_in, const int* in_sizes, int n_in, void* d_out, int out_size, void* d_ws, size_t ws_size, hipStream_t stream) {
    static int grid = 0;
    if (grid == 0) {
        if (n_in != 23 || in_sizes[0] != NP * D || (size_t)out_size != O_END || ws_size < WS_END) {
            fprintf(stderr, "kernel_launch: unexpected shapes: n_in %d in0 %d out %d (want %zu) ws %zu (want %zu); nothing launched\n", n_in, n_in > 0 ? in_sizes[0] : -1, out_size, (size_t)O_END, ws_size, (size_t)WS_END); grid = -1; return; }
        int dev = 0, cus = 0, per_cu = 0;
        if (hipGetDevice(&dev) != hipSuccess || hipDeviceGetAttribute(&cus, hipDeviceAttributeMultiprocessorCount, dev) != hipSuccess) { fprintf(stderr, "kernel_launch: device query failed\n"); grid = -1; return; }
        if (hipFuncSetAttribute((const void*)mk_fwd, hipFuncAttributeMaxDynamicSharedMemorySize, LDS_BYTES) != hipSuccess) { fprintf(stderr, "kernel_launch: hipFuncSetAttribute failed\n"); grid = -1; return; }
        if (hipOccupancyMaxActiveBlocksPerMultiprocessor(&per_cu, (const void*)mk_fwd, NWAVES * 64, LDS_BYTES) != hipSuccess || per_cu < 1)
            fprintf(stderr, "kernel_launch: note: occupancy query reports %d workgroups per CU\n", per_cu);
        (void)hipGetLastError();
        grid = cus;
    }
    if (grid < 0) return;
    if (hipMemsetAsync((char*)d_ws + WS_CTL, 0, CTL_ZERO_BYTES, stream) != hipSuccess) { fprintf(stderr, "kernel_launch: memset failed\n"); return; }
    Args a{};
    for (int i = 0; i < 23; ++i) a.in[i] = (const float*)d_in[i];
    a.out = (float*)d_out; a.ws = (unsigned char*)d_ws;
    if (MK_N_LAUNCHES == 1) { a.ph_lo = 0; a.ph_hi = N_PHASES; hipLaunchKernelGGL(mk_fwd, dim3(grid), dim3(NWAVES * 64), LDS_BYTES, stream, a); }
    else { for (int p = 0; p < N_PHASES; ++p) { a.ph_lo = p; a.ph_hi = p + 1; hipLaunchKernelGGL(mk_fwd, dim3(grid), dim3(NWAVES * 64), LDS_BYTES, stream, a); } }
    const hipError_t le = hipPeekAtLastError();
    if (le != hipSuccess) fprintf(stderr, "kernel_launch: launch failed: %s\n", hipGetErrorName(le));
}
```

```cpp
#include <hip/hip_runtime.h>
#include <cstdio>
#include <cstdint>
namespace pg8 {
#define PG8_LAS __attribute__((address_space(3)))
typedef unsigned short bf16_t;
typedef short bf16x8 __attribute__((ext_vector_type(8)));
typedef float f32x4 __attribute__((ext_vector_type(4)));
typedef unsigned u32x4 __attribute__((ext_vector_type(4)));
constexpr int BM = 256, BK = 64, HALF = 128, HTB = HALF * BK * 2  , STAGE_BYTES = 8 * HTB, NXCD = 8, WGM = 8;

__host__ __device__ __forceinline__ int lds_byte(int r, int c) { const int st = (r >> 4) * 2 + (c >> 5), rr = r & 15, cc = c & 31, ob = rr * 64 + cc * 2; return st * 1024 + (ob ^ (((ob >> 9) & 1) << 5)); }
__host__ __device__ __forceinline__ void stage_rc(int b, int& R, int& C) { const int st = b / 1024, sb = b % 1024, swz = sb ^ (((sb >> 9) & 1) << 5); R = (st >> 1) * 16 + swz / 64; C = (st & 1) * 32 + (swz % 64) / 2; }
__host__ __device__ __forceinline__ int perm32(int rho) { const int n = rho >> 4, i = rho & 15; return 8 * (i >> 2) + 4 * n + (i & 3); }

struct Unit { int pm, pn, ks; };
struct Gemm { const bf16_t* A; const bf16_t* Bt; int M, N, K, ldk; };

struct StaticOrder {
    int nM, nN, nwg, G, c;
    __host__ __device__ void init(int M, int N, int G_, int c_) { nM = M / BM; nN = N / BM; nwg = nM * nN; G = G_; c = c_; }
    __host__ __device__ bool next(int i, Unit& u) const {
        const long L = (long)i * G + c; if (L >= nwg) return false;
        int wgid = (int)L; { const int q = nwg / NXCD, r = nwg % NXCD, xcd = wgid % NXCD, off = wgid / NXCD; wgid = (xcd < r ? xcd * (q + 1) : r * (q + 1) + (xcd - r) * q) + off; }
        const int nig = WGM * nN, gid = wgid / nig, fm = gid * WGM, gsz = (nM - fm) < WGM ? (nM - fm) : WGM;
        u.pm = fm + ((wgid % nig) % gsz); u.pn = (wgid % nig) / gsz; u.ks = 0; return true;
    }
    __device__ __forceinline__ void a_ready(const Unit&) const {}
    __device__ __forceinline__ void done(const Unit&) const {}
};


typedef float cvt_f32x2 __attribute__((ext_vector_type(2)));
typedef __bf16 cvt_bf16x2 __attribute__((ext_vector_type(2)));
__device__ __forceinline__ unsigned cvt_pk_bf16(float lo, float hi) { const cvt_f32x2 v = {lo, hi}; return __builtin_bit_cast(unsigned, __builtin_convertvector(v, cvt_bf16x2)); }
constexpr float RMS_EPS = 1e-6f;
constexpr int DMODEL = 4096;
template <int ACT> struct EpiRow {
    static constexpr bool PERM = true, AFTER_DRAIN = false;
    bf16_t* O; int ldc; const float* ssq; float* aux; int pn_aux;
    __device__ __forceinline__ void operator()(const f32x4 (&acc)[2][2][4][2], const Unit& u, int wr, int wc, int fr, int fq) const {
        const int row0 = u.pm * BM + wr * 64 + fr, ct = wc * 32 + 8 * fq;
        const bool isaux = (u.pn == pn_aux);
#pragma unroll
        for (int ai = 0; ai < 2; ++ai)
#pragma unroll
            for (int m = 0; m < 4; ++m) {
                const int row = row0 + ai * HALF + m * 16;
                const float rs = rsqrtf(ssq[row] * (1.0f / DMODEL) + RMS_EPS);
#pragma unroll
                for (int bj = 0; bj < 2; ++bj) {
                    f32x4 v0 = acc[ai][bj][m][0] * rs, v1 = acc[ai][bj][m][1] * rs;
                    if (ACT == 1) {
#pragma unroll
                        for (int j = 0; j < 4; ++j) { const float a = fmaxf(v0[j], 0.f), b = fmaxf(v1[j], 0.f); v0[j] = a * a; v1[j] = b * b; }
                    }
                    if (isaux) {
                        if (bj == 0 && ct < 64) { float* p = aux + (size_t)row * 64 + ct; *(f32x4*)p = v0; *(f32x4*)(p + 4) = v1; }
                    } else {
                        u32x4 w; w.x = cvt_pk_bf16(v0[0], v0[1]); w.y = cvt_pk_bf16(v0[2], v0[3]); w.z = cvt_pk_bf16(v1[0], v1[1]); w.w = cvt_pk_bf16(v1[2], v1[3]);
                        *(u32x4*)(O + (size_t)row * ldc + u.pn * BM + ct + bj * HALF) = w;
                    }
                }
            }
    }
};
struct SplitOrder {
    int nN, nsplit, G, c;
    __device__ bool next(int i, Unit& u) const { const int L = i * G + c; if (L >= nN * nsplit) return false; u.pm = 0; u.pn = L / nsplit; u.ks = L % nsplit; return true; }
    __device__ __forceinline__ void a_ready(const Unit&) const {}
    __device__ __forceinline__ void done(const Unit&) const {}
};
struct EpiSlab {
    static constexpr bool PERM = false, AFTER_DRAIN = false;
    float* slab; int nsplit;
    __device__ __forceinline__ void operator()(const f32x4 (&acc)[2][2][4][2], const Unit& u, int wr, int wc, int fr, int fq) const {
        float* sb = slab + (size_t)(u.pn * nsplit + u.ks) * 65536 + (size_t)(wr * 64 + fr) * 256 + wc * 32 + 4 * fq;
#pragma unroll
        for (int ai = 0; ai < 2; ++ai)
#pragma unroll
            for (int m = 0; m < 4; ++m)
#pragma unroll
                for (int bj = 0; bj < 2; ++bj)
#pragma unroll
                    for (int n = 0; n < 2; ++n) *(f32x4*)(sb + (size_t)(ai * HALF + m * 16) * 256 + bj * HALF + n * 16) = acc[ai][bj][m][n];
    }
};
template <bool BASE_F32, bool OUT_F32> struct EpiRes {
    static constexpr bool PERM = true, AFTER_DRAIN = false;
    const void* base; void* out; float* ssq;
    __device__ __forceinline__ void operator()(const f32x4 (&acc)[2][2][4][2], const Unit& u, int wr, int wc, int fr, int fq) const {
        const int row0 = u.pm * BM + wr * 64 + fr, col0 = u.pn * BM + wc * 32 + 8 * fq;
#pragma unroll
        for (int ai = 0; ai < 2; ++ai)
#pragma unroll
            for (int m = 0; m < 4; ++m) {
                const int row = row0 + ai * HALF + m * 16; const size_t off = (size_t)row * DMODEL + col0;
                float s = 0.f;
#pragma unroll
                for (int bj = 0; bj < 2; ++bj) {
                    f32x4 b0, b1;
                    if (BASE_F32) { b0 = *(const f32x4*)((const float*)base + off + bj * HALF); b1 = *(const f32x4*)((const float*)base + off + bj * HALF + 4); }
                    else { const u32x4 w = *(const u32x4*)((const bf16_t*)base + off + bj * HALF);
                        b0[0] = __builtin_bit_cast(float, w.x << 16); b0[1] = __builtin_bit_cast(float, w.x & 0xffff0000u); b0[2] = __builtin_bit_cast(float, w.y << 16); b0[3] = __builtin_bit_cast(float, w.y & 0xffff0000u);
                        b1[0] = __builtin_bit_cast(float, w.z << 16); b1[1] = __builtin_bit_cast(float, w.z & 0xffff0000u); b1[2] = __builtin_bit_cast(float, w.w << 16); b1[3] = __builtin_bit_cast(float, w.w & 0xffff0000u); }
                    const f32x4 o0 = b0 + acc[ai][bj][m][0], o1 = b1 + acc[ai][bj][m][1];
                    s += ((o0[0] * o0[0] + o0[1] * o0[1]) + (o0[2] * o0[2] + o0[3] * o0[3])) + ((o1[0] * o1[0] + o1[1] * o1[1]) + (o1[2] * o1[2] + o1[3] * o1[3]));
                    if (OUT_F32) { *(f32x4*)((float*)out + off + bj * HALF) = o0; *(f32x4*)((float*)out + off + bj * HALF + 4) = o1; }
                    else { u32x4 w; w.x = cvt_pk_bf16(o0[0], o0[1]); w.y = cvt_pk_bf16(o0[2], o0[3]); w.z = cvt_pk_bf16(o1[0], o1[1]); w.w = cvt_pk_bf16(o1[2], o1[3]); *(u32x4*)((bf16_t*)out + off + bj * HALF) = w; }
                }
                s += __shfl_xor(s, 16); s += __shfl_xor(s, 32);
                if (fq == 0) ssq[(size_t)row * 64 + u.pn * 4 + wc] = s;
            }
    }
};
__device__ __forceinline__ __amdgpu_buffer_rsrc_t mk_rsrc(const void* p) {
    const unsigned lo = __builtin_amdgcn_readfirstlane((unsigned)(size_t)p), hi = __builtin_amdgcn_readfirstlane((unsigned)((size_t)p >> 32));
    return __builtin_amdgcn_make_buffer_rsrc((void*)(((size_t)hi << 32) | lo), 0, 0xFFFFF000u, 0x00020000);
}
template <class Epi, class Sched, bool ALIGN_EPI = false, bool SP2 = false>
__device__ __forceinline__ void gemm_phase(PG8_LAS unsigned char* lds, const Gemm g, const Sched& S, const Epi& E) {
    const int tid = threadIdx.x, wid = __builtin_amdgcn_readfirstlane(tid >> 6), lane = tid & 63, wr = wid >> 2, wc = wid & 3, fr = lane & 15, fq = lane >> 4;
    const int K = g.K, nt = K / BK;
    unsigned voffA[2], voffB[2];
#pragma unroll
    for (int i = 0; i < 2; ++i) { int R, C; stage_rc(tid * 16 + i * 8192, R, C); const int Rb = Epi::PERM ? ((R & ~31) + perm32(R & 31)) : R;
        voffA[i] = (unsigned)(R * g.ldk + C) * 2u; voffB[i] = (unsigned)(Rb * g.ldk + C) * 2u; }
    const unsigned kstep = (unsigned)(BK * 2);
    const unsigned hstep = (unsigned)(HALF * g.ldk * 2);
    const unsigned tstep = 2 * hstep;
    const unsigned ldsw = (unsigned)wid * 1024u;
    const int aoff = lds_byte(wr * 64 + fr, fq * 8), boff = lds_byte(wc * 32 + fr, fq * 8);
#define PG8_SA(b, h) (((b) * 2 + (h)) * HTB)
#define PG8_SB(b, h) ((4 + (b) * 2 + (h)) * HTB)
    const __amdgpu_buffer_rsrc_t rs_voffA = mk_rsrc(g.A), rs_voffB = mk_rsrc(g.Bt);
#define PG8_STAGE(bufoff, soff, voff) do { _Pragma("unroll") for (int _i = 0; _i < 2; ++_i) \
        __builtin_amdgcn_raw_ptr_buffer_load_lds(rs_##voff, (PG8_LAS void*)(lds + (bufoff) + ldsw + _i * 8192), 16, (voff)[_i], (soff), 0, 0); } while (0)
#define PG8_LDA(dst, b, h) do { _Pragma("unroll") for (int m = 0; m < 4; ++m) _Pragma("unroll") for (int k = 0; k < 2; ++k) dst[m][k] = *(const PG8_LAS bf16x8*)(lds + PG8_SA(b, h) + aoff + m * 2048 + k * 1024); } while (0)
#define PG8_LDB(dst, b, h) do { _Pragma("unroll") for (int n = 0; n < 2; ++n) _Pragma("unroll") for (int k = 0; k < 2; ++k) dst[n][k] = *(const PG8_LAS bf16x8*)(lds + PG8_SB(b, h) + boff + n * 2048 + k * 1024); } while (0)
#define PG8_MMA(ai, bj, At, Bt) do { __builtin_amdgcn_s_setprio(1); _Pragma("unroll") for (int m = 0; m < 4; ++m) _Pragma("unroll") for (int n = 0; n < 2; ++n) _Pragma("unroll") for (int k = 0; k < 2; ++k) \
        acc[ai][bj][m][n] = __builtin_amdgcn_mfma_f32_16x16x32_bf16(Bt[n][k], At[m][k], acc[ai][bj][m][n], 0, 0, 0); __builtin_amdgcn_s_setprio(0); } while (0)
#define PG8_WAIT_V(n) asm volatile("s_waitcnt vmcnt(" #n ")" ::: "memory")
#define PG8_WAIT_L(n) asm volatile("s_waitcnt lgkmcnt(" #n ")" ::: "memory")
#define PG8_BAR __builtin_amdgcn_s_barrier()
#define PG8_SCHED __builtin_amdgcn_sched_barrier(0)
    Unit cur, nxt; int ui = 0;
    if (!S.next(0, cur)) return;
    f32x4 acc[2][2][4][2];
#pragma unroll
    for (int a = 0; a < 2; ++a)
#pragma unroll
        for (int b = 0; b < 2; ++b)
#pragma unroll
            for (int m = 0; m < 4; ++m)
#pragma unroll
                for (int n = 0; n < 2; ++n) acc[a][b][m][n] = (f32x4){0.f, 0.f, 0.f, 0.f};
    bf16x8 At[4][2], B0[2][2], B1[2][2];
    unsigned cA = (unsigned)cur.pm * tstep + (unsigned)(cur.ks * K * 2), cB = (unsigned)cur.pn * tstep + (unsigned)(cur.ks * K * 2);
    S.a_ready(cur);
    if constexpr (SP2) {
        PG8_STAGE(PG8_SB(0, 0), cB, voffB); PG8_STAGE(PG8_SB(0, 1), cB + hstep, voffB); PG8_STAGE(PG8_SA(0, 0), cA, voffA); PG8_STAGE(PG8_SA(0, 1), cA + hstep, voffA);
        if (wr == 1) PG8_BAR;
        PG8_WAIT_V(2); PG8_BAR;
        PG8_STAGE(PG8_SB(1, 0), cB + kstep, voffB); PG8_STAGE(PG8_SA(1, 0), cA + kstep, voffA); PG8_STAGE(PG8_SB(1, 1), cB + hstep + kstep, voffB);
        PG8_WAIT_V(6); PG8_BAR;
    } else {
        PG8_STAGE(PG8_SB(0, 0), cB, voffB); PG8_STAGE(PG8_SA(0, 0), cA, voffA); PG8_STAGE(PG8_SB(0, 1), cB + hstep, voffB); PG8_STAGE(PG8_SA(0, 1), cA + hstep, voffA);
        if (wr == 1) PG8_BAR;
        PG8_WAIT_V(4); PG8_BAR;
        PG8_STAGE(PG8_SB(1, 0), cB + kstep, voffB); PG8_STAGE(PG8_SA(1, 0), cA + kstep, voffA); PG8_STAGE(PG8_SB(1, 1), cB + hstep + kstep, voffB);
        PG8_WAIT_V(6); PG8_BAR;
    }
    for (;;) {
        const bool has_next = S.next(ui + 1, nxt);
        const unsigned nA = has_next ? (unsigned)nxt.pm * tstep + (unsigned)(nxt.ks * K * 2) : cA, nB = has_next ? (unsigned)nxt.pn * tstep + (unsigned)(nxt.ks * K * 2) : cB;
        for (int t = 0; t < nt; t += 2) {
            const bool last = (t == nt - 2);
            const unsigned a1 = cA + (unsigned)(t + 1) * kstep;
            const unsigned a2 = last ? nA : cA + (unsigned)(t + 2) * kstep, b2 = last ? nB : cB + (unsigned)(t + 2) * kstep;
            const unsigned a3 = a2 + kstep, b3 = b2 + kstep;
            if (last && has_next) S.a_ready(nxt);
            if constexpr (SP2) {
            PG8_LDB(B0, 0, 0); PG8_LDB(B1, 0, 1); PG8_SCHED; PG8_LDA(At, 0, 0); PG8_STAGE(PG8_SA(1, 1), a1 + hstep, voffA);
            PG8_WAIT_V(8); PG8_WAIT_L(0); PG8_BAR; PG8_MMA(0, 0, At, B0); PG8_MMA(0, 1, At, B1); PG8_BAR; PG8_SCHED;
            PG8_LDA(At, 0, 1); PG8_STAGE(PG8_SB(0, 0), b2, voffB); PG8_STAGE(PG8_SB(0, 1), b2 + hstep, voffB); PG8_STAGE(PG8_SA(0, 0), a2, voffA);
            PG8_WAIT_V(8); PG8_WAIT_L(0); PG8_BAR; PG8_MMA(1, 0, At, B0); PG8_MMA(1, 1, At, B1); PG8_BAR; PG8_SCHED;
            PG8_LDB(B0, 1, 0); PG8_LDB(B1, 1, 1); PG8_SCHED; PG8_LDA(At, 1, 0); PG8_STAGE(PG8_SA(0, 1), a2 + hstep, voffA);
            PG8_WAIT_V(8); PG8_WAIT_L(0); PG8_BAR; PG8_MMA(0, 0, At, B0); PG8_MMA(0, 1, At, B1); PG8_BAR; PG8_SCHED;
            PG8_LDA(At, 1, 1); PG8_STAGE(PG8_SB(1, 0), b3, voffB); PG8_STAGE(PG8_SB(1, 1), b3 + hstep, voffB); PG8_STAGE(PG8_SA(1, 0), a3, voffA);
            PG8_WAIT_V(8); PG8_WAIT_L(0); PG8_BAR; PG8_MMA(1, 0, At, B0); PG8_MMA(1, 1, At, B1); PG8_BAR; PG8_SCHED;
            } else {
            PG8_LDB(B0, 0, 0); PG8_SCHED; PG8_LDA(At, 0, 0); PG8_STAGE(PG8_SA(1, 1), a1 + hstep, voffA);
            PG8_WAIT_L(8); PG8_BAR; PG8_WAIT_L(0); PG8_MMA(0, 0, At, B0); PG8_BAR; PG8_SCHED;
            PG8_LDB(B1, 0, 1); PG8_STAGE(PG8_SB(0, 0), b2, voffB);
            PG8_BAR; PG8_WAIT_L(0); PG8_MMA(0, 1, At, B1); PG8_BAR;
            PG8_LDA(At, 0, 1); PG8_STAGE(PG8_SA(0, 0), a2, voffA);
            PG8_BAR; PG8_WAIT_L(0); PG8_MMA(1, 0, At, B0); PG8_BAR; PG8_SCHED;
            PG8_STAGE(PG8_SB(0, 1), b2 + hstep, voffB);
            PG8_WAIT_V(6); PG8_BAR; PG8_MMA(1, 1, At, B1); PG8_BAR;
            PG8_LDB(B0, 1, 0); PG8_SCHED; PG8_LDA(At, 1, 0); PG8_STAGE(PG8_SA(0, 1), a2 + hstep, voffA);
            PG8_WAIT_L(8); PG8_BAR; PG8_WAIT_L(0); PG8_MMA(0, 0, At, B0); PG8_BAR; PG8_SCHED;
            PG8_LDB(B1, 1, 1); PG8_STAGE(PG8_SB(1, 0), b3, voffB);
            PG8_BAR; PG8_WAIT_L(0); PG8_MMA(0, 1, At, B1); PG8_BAR;
            PG8_LDA(At, 1, 1); PG8_STAGE(PG8_SA(1, 0), a3, voffA);
            PG8_BAR; PG8_WAIT_L(0); PG8_MMA(1, 0, At, B0); PG8_BAR; PG8_SCHED;
            PG8_STAGE(PG8_SB(1, 1), b3 + hstep, voffB);
            PG8_WAIT_V(6); PG8_BAR; PG8_MMA(1, 1, At, B1); PG8_BAR;
            }
        }
        if constexpr (ALIGN_EPI) { if (wr == 0) PG8_BAR; }
        if constexpr (!Epi::AFTER_DRAIN) { E(acc, cur, wr, wc, fr, fq); S.done(cur); }
        if (!has_next) break;
#pragma unroll
        for (int a = 0; a < 2; ++a)
#pragma unroll
            for (int b = 0; b < 2; ++b)
#pragma unroll
                for (int m = 0; m < 4; ++m)
#pragma unroll
                    for (int n = 0; n < 2; ++n) acc[a][b][m][n] = (f32x4){0.f, 0.f, 0.f, 0.f};
        cur = nxt; cA = nA; cB = nB; ++ui;
        if constexpr (ALIGN_EPI) { if (wr == 1) PG8_BAR; }
    }
    PG8_WAIT_V(0);
    if constexpr (!ALIGN_EPI) { if (wr == 0) PG8_BAR; }
    PG8_BAR;
    if constexpr (Epi::AFTER_DRAIN) { E.fused(acc, cur, wr, wc, fr, fq, lds, wid, lane); S.done(cur); }
#undef PG8_SA
#undef PG8_SB
#undef PG8_STAGE
#undef PG8_LDA
#undef PG8_LDB
#undef PG8_MMA
#undef PG8_WAIT_V
#undef PG8_WAIT_L
#undef PG8_BAR
#undef PG8_SCHED
}
}

#define GAS __attribute__((address_space(1)))
#define LAS __attribute__((address_space(3)))
typedef unsigned short bf16;
typedef unsigned v4u __attribute__((ext_vector_type(4)));
typedef float f32x4 __attribute__((ext_vector_type(4)));
typedef short bf16x8 __attribute__((ext_vector_type(8)));
typedef GAS unsigned gu32;
typedef GAS unsigned long long gu64;
#define RLX_AGENT __ATOMIC_RELAXED, __HIP_MEMORY_SCOPE_AGENT
#define LDS_WAIT() asm volatile("s_waitcnt lgkmcnt(0)" ::: "memory")
#define VM_WAIT() asm volatile("s_waitcnt vmcnt(0)" ::: "memory")
__device__ __forceinline__ unsigned long long rt() { return __builtin_amdgcn_s_memrealtime(); }
__device__ __forceinline__ unsigned f2bf(float f) { unsigned u = __builtin_bit_cast(unsigned, f); return (u + 0x7fffu + ((u >> 16) & 1u)) >> 16; }
__device__ __forceinline__ unsigned pk2(float lo, float hi) { return pg8::cvt_pk_bf16(lo, hi); }

#define XB_TMO      128
#define XB_XCNT(j)  (256  + 64 * (j))
#define XB_XSUB(j)  (1280 + 64 * (j))
#define XB_XGEN(j)  (2304 + 64 * (j))
#define XB_TOP      3328
#define XB_TOPGEN   3392
#define XCD_BAR_WORDS 3456
#define XB_SPIN_CAP (1u << 18)

__device__ __forceinline__ unsigned xb_ld(unsigned* p)              { return __hip_atomic_load(p, __ATOMIC_RELAXED, __HIP_MEMORY_SCOPE_AGENT); }
__device__ __forceinline__ unsigned xb_add(unsigned* p, unsigned v) { return __hip_atomic_fetch_add(p, v, __ATOMIC_RELAXED, __HIP_MEMORY_SCOPE_AGENT); }
__device__ __forceinline__ unsigned xb_xcc_id() { return (unsigned)__builtin_amdgcn_s_getreg((3 << 11) | 20) & 0xFu; }
#define XB_SPIN(cond, bar) do { unsigned _sp = 0; while (cond) { __builtin_amdgcn_s_sleep(1); \
    if ((++_sp & 255u) == 0u) { if (xb_ld(&(bar)[XB_TMO])) break; if (_sp > XB_SPIN_CAP) { atomicAdd(&(bar)[XB_TMO], 1u); break; } } } } while (0)

struct XcdBarrier {
    unsigned* bar; unsigned x;
    volatile LAS unsigned* st;
};

__device__ __forceinline__ XcdBarrier xcd_barrier_post(unsigned* bar, volatile LAS unsigned* st) {
    XcdBarrier b; b.bar = bar; b.x = xb_xcc_id(); b.st = st;
    if (threadIdx.x == 0) (void)xb_add(&bar[XB_XCNT(b.x)], 1u);
    return b;
}
__device__ __forceinline__ void xcd_barrier_complete(unsigned* bar, unsigned x, unsigned& nloc, unsigned& nx) {
    const unsigned G = gridDim.x * gridDim.y * gridDim.z;
    unsigned sum, cnt, mine, sp = 0u;
    for (;;) {
        sum = 0u; cnt = 0u; mine = 0u;
#pragma unroll
        for (unsigned j = 0; j < 16; ++j) { const unsigned c = xb_ld(&bar[XB_XCNT(j)]); sum += c; cnt += (c > 0u) ? 1u : 0u; mine = (j == x) ? c : mine; }
        if (sum == G) break;
        __builtin_amdgcn_s_sleep(1);
        if ((++sp & 255u) == 0u) { if (xb_ld(&bar[XB_TMO])) break; if (sp > XB_SPIN_CAP) { atomicAdd(&bar[XB_TMO], 1u); break; } }
    }
    nloc = mine > 0u ? mine : 1u; nx = cnt > 0u ? cnt : 1u;
}

__device__ __forceinline__ void xcd_barrier(const XcdBarrier& b) {
    asm volatile("s_waitcnt vmcnt(0)" ::: "memory");
    __syncthreads();
    if (threadIdx.x == 0) {
        unsigned* bar = b.bar;
        __builtin_amdgcn_s_waitcnt(0);
        unsigned nloc = b.st[0], nx = b.st[1];
        if (nloc == 0u) { xcd_barrier_complete(bar, b.x, nloc, nx); b.st[0] = nloc; b.st[1] = nx; }
        const unsigned old = xb_add(&bar[XB_XSUB(b.x)], 1u);
        const unsigned gen = old / nloc;
        if (old + 1u == (gen + 1u) * nloc) {
            __builtin_amdgcn_fence(__ATOMIC_RELEASE, "agent");
            asm volatile("s_waitcnt vmcnt(0)" ::: "memory");
            const unsigned og = xb_add(&bar[XB_TOP], 1u);
            const unsigned tg = og / nx;
            if (og + 1u == (tg + 1u) * nx) xb_add(&bar[XB_TOPGEN], 1u);
            else XB_SPIN(xb_ld(&bar[XB_TOPGEN]) == tg, bar);
            __builtin_amdgcn_fence(__ATOMIC_ACQUIRE, "agent");
            xb_add(&bar[XB_XGEN(b.x)], 1u);
            asm volatile("s_waitcnt vmcnt(0)" ::: "memory");
        } else {
            XB_SPIN(xb_ld(&bar[XB_XGEN(b.x)]) == gen, bar);
            __builtin_amdgcn_fence(__ATOMIC_ACQUIRE, "agent");
            asm volatile("s_waitcnt vmcnt(0)" ::: "memory");
        }
    }
    __syncthreads();
}

constexpr int NWAVES = 8;
#ifndef MK_N_LAUNCHES
#define MK_N_LAUNCHES 1
#endif
constexpr int N_PHASES = 12;
constexpr int D = 4096, SEQ = 2048, NB = 8, NSB = 16, NST = 16, PAST = 4096;
constexpr int NP = NB * SEQ;
constexpr int M = NP + NSB * NST;
constexpr int IN0 = 8704, IN1 = 16448, IN1M = 16384, IN1P = 16640, DFF = 16384;
constexpr int C_K = 2048, C_V = 2304, C_B = 2560, C_C = 4608, C_X = 6656;
constexpr int NH = 32, HD = 64, NKV = 4, GDH = 128, QKV = 12288;
constexpr size_t MiB = 1u << 20;
constexpr size_t WS_CTL = 0, CTL_ZERO_BYTES = 64 * 1024;
constexpr size_t WS_SSQ = 1 * MiB;
constexpr size_t WS_ROPE = 2 * MiB;
constexpr size_t WS_AUX = 3 * MiB;
constexpr size_t WS_WINA = 8 * MiB;
constexpr size_t WS_WOUTA = WS_WINA + 68 * MiB;
constexpr size_t WS_WING = WS_WOUTA + 32 * MiB;
constexpr size_t WS_WOUTG = WS_WING + 130 * MiB;
constexpr size_t WS_WUP = WS_WOUTG + 32 * MiB;
constexpr size_t WS_WDN = WS_WUP + 256 * MiB;
constexpr size_t WS_XB = WS_WDN + 256 * MiB;
constexpr size_t WS_MIX = WS_XB + 130 * MiB;
constexpr size_t WS_XRES = WS_MIX + 130 * MiB;
constexpr size_t WS_BIG = WS_XRES + 260 * MiB;
constexpr size_t WS_SLAB = WS_BIG + 520 * MiB;
constexpr size_t WS_SSQP = WS_SLAB + 64 * MiB;
constexpr size_t WS_END = WS_SSQP + 4 * MiB;
static_assert((size_t)M * D * 2 <= 130 * MiB && (size_t)M * D * 4 <= 260 * MiB && (size_t)M * DFF * 2 <= 520 * MiB && (size_t)IN1P * D * 2 <= 130 * MiB, "ws map");
constexpr int CW_CLAIM = 12032;
constexpr int CW_BAR = 4096;
constexpr int RING_BYTES = 131072;
constexpr int LDS_BYTES = 147456;
constexpr int MISC_OFF = LDS_BYTES - 256;
constexpr int SMALL_OFF = 133120;

typedef float f32x4v __attribute__((ext_vector_type(4)));
constexpr float RMS6 = 1e-6f;
__device__ __forceinline__ float bf2f(unsigned short b) { return __builtin_bit_cast(float, (unsigned)b << 16); }
__device__ __forceinline__ void unpack8(const v4u w, float* f) {
    f[0] = __builtin_bit_cast(float, w.x << 16); f[1] = __builtin_bit_cast(float, w.x & 0xffff0000u);
    f[2] = __builtin_bit_cast(float, w.y << 16); f[3] = __builtin_bit_cast(float, w.y & 0xffff0000u);
    f[4] = __builtin_bit_cast(float, w.z << 16); f[5] = __builtin_bit_cast(float, w.z & 0xffff0000u);
    f[6] = __builtin_bit_cast(float, w.w << 16); f[7] = __builtin_bit_cast(float, w.w & 0xffff0000u);
}
__device__ __forceinline__ v4u pack8(const float* f) { v4u o; o.x = pk2(f[0], f[1]); o.y = pk2(f[2], f[3]); o.z = pk2(f[4], f[5]); o.w = pk2(f[6], f[7]); return o; }
__device__ __forceinline__ float wave_sum(float v) {
#pragma unroll
    for (int o = 1; o < 64; o <<= 1) v += __shfl_xor(v, o);
    return v;
}
__device__ __forceinline__ float siluf(float x) { return x * __builtin_amdgcn_rcpf(1.0f + __expf(-x)); }

struct Args { const float* in[23]; float* out; unsigned char* ws; int ph_lo, ph_hi; };
enum { I_XP = 0, I_XS, I_CK, I_CV, I_SSC, I_SDC, I_SDN, I_ANORM, I_WINA, I_SINKS, I_SCW, I_WOUTA, I_DNORM, I_WING, I_DCW, I_ALOG, I_DTB, I_ONW, I_WOUTG, I_MNORM, I_WUP, I_WDN, I_FNORM };
constexpr size_t O_Y = 0;
constexpr size_t O_KP = (size_t)M * D;
constexpr size_t O_VP = O_KP + 8 * 128 * 256;
constexpr size_t O_KS = O_VP + 8 * 128 * 256;
constexpr size_t O_VS = O_KS + 16 * 128 * 256;
constexpr size_t O_CP = O_VS + 16 * 128 * 256;
constexpr size_t O_CS = O_CP + 8 * 2 * 2048;
constexpr size_t O_DCP = O_CS + 16 * 2 * 2048;
constexpr size_t O_DCS = O_DCP + 8 * 3 * 12288;
constexpr size_t O_DSP = O_DCS + 16 * 3 * 12288;
constexpr size_t O_DSS = O_DSP + (size_t)8 * 32 * 128 * 128;
constexpr size_t O_END = O_DSS + (size_t)16 * 32 * 128 * 128;

struct Frame {
    LAS unsigned char* lds; int tid, lane, wave, vcu, G;
};
constexpr int DEF_Q1 = 168, DEF_Q6 = 128, DEF_WG1 = 162, DEF_WG6 = 129, DEF_N1 = (256 - DEF_WG1) * DEF_Q1, DEF_N6 = (256 - DEF_WG6) * DEF_Q6;
static_assert(DEF_N1 <= 256 * 64 && DEF_N6 <= 64 * 256, "deferred items inside one layer's matrix");

__device__ __forceinline__ void p0_item(const float* W, int ldw, const float* gain, bf16* WT, int K, int k0, int n0, LAS float* scr, int lane) {
#pragma unroll 4
    for (int i = 0; i < 16; ++i) { const int kk = 4 * i + (lane >> 4);
        f32x4v v = __builtin_nontemporal_load((const f32x4v*)(W + (size_t)(k0 + kk) * ldw + n0 + 4 * (lane & 15)));
        const float g = gain ? gain[k0 + kk] : 1.0f; LAS float* s = scr + kk * 65 + 4 * (lane & 15);
        s[0] = v.x * g; s[1] = v.y * g; s[2] = v.z * g; s[3] = v.w * g; }
    LDS_WAIT(); asm volatile("" ::: "memory");
    const int c = lane & 7;
#pragma unroll
    for (int j = 0; j < 8; ++j) { const int n = (lane >> 3) + 8 * j; const LAS float* s = scr + (8 * c) * 65 + n;
        v4u o; o.x = pk2(s[0 * 65], s[1 * 65]); o.y = pk2(s[2 * 65], s[3 * 65]); o.z = pk2(s[4 * 65], s[5 * 65]); o.w = pk2(s[6 * 65], s[7 * 65]);
        *(GAS v4u*)(WT + (size_t)(n0 + n) * K + k0 + 8 * c) = o; }
    LDS_WAIT(); asm volatile("" ::: "memory");
}
constexpr int CW_S1 = 64, CW_S2 = CW_S1 + 256, CW_S3 = CW_S2 + 256, CW_S4 = CW_S3 + 257, CW_S5 = CW_S4 + 64, CW_S6 = CW_S5 + (16384 - DEF_N6) / 64, CW_END = CW_S6 + 256;
static_assert((16384 - DEF_N6) % 64 == 0, "the w_up[1] tail is whole chunks");
#ifndef CW_P0
#define CW_P0 0
#endif
__device__ __forceinline__ void conv_chunk(const Frame& F, const Args& a, int q) {
    LAS float* scr = (LAS float*)(F.lds + F.wave * 16640);
    const int lane = F.lane, c8 = lane & 7;
    const float* W; const float* gain = nullptr; bf16* WT; int ldw, K, ncol, r0;
    if (q < CW_S1)      { W = a.in[I_WOUTA]; WT = (bf16*)(a.ws + WS_WOUTA); ldw = D; K = D; ncol = 64; r0 = q * 64; }
    else if (q < CW_S2) { W = a.in[I_WUP]; gain = a.in[I_MNORM]; WT = (bf16*)(a.ws + WS_WUP); ldw = DFF; K = D; ncol = 256; r0 = (q - CW_S1) * 64; }
    else if (q < CW_S3) { W = a.in[I_WDN]; WT = (bf16*)(a.ws + WS_WDN); ldw = D; K = DFF; ncol = 64; r0 = (q - CW_S2) * 64; }
    else if (q < CW_S4) { W = a.in[I_WING]; gain = a.in[I_DNORM]; WT = (bf16*)(a.ws + WS_WING); ldw = IN1; K = D; ncol = 257; r0 = (q - CW_S3) * 64; }
    else if (q < CW_S5) { W = a.in[I_WOUTG]; WT = (bf16*)(a.ws + WS_WOUTG); ldw = D; K = D; ncol = 64; r0 = (q - CW_S4) * 64; }
    else if (q < CW_S6) { W = a.in[I_WUP] + (size_t)D * DFF; gain = a.in[I_MNORM] + D; WT = (bf16*)(a.ws + WS_WUP) + (size_t)DFF * D; ldw = DFF; K = D; ncol = 256; r0 = DEF_N6 + (q - CW_S5) * 64; }
    else                { W = a.in[I_WDN] + (size_t)DFF * D; WT = (bf16*)(a.ws + WS_WDN) + (size_t)D * DFF; ldw = D; K = DFF; ncol = 64; r0 = (q - CW_S6) * 64; }
    f32x4v buf[16];
    int r = r0 + F.wave; int k0 = 64 * (r / ncol), n0 = 64 * (r % ncol);
#pragma unroll
    for (int i = 0; i < 16; ++i) buf[i] = __builtin_nontemporal_load((const f32x4v*)(W + (size_t)(k0 + 4 * i + (lane >> 4)) * ldw + n0 + 4 * (lane & 15)));
    for (int it = 0; it < 8; ++it) {
#pragma unroll
        for (int i = 0; i < 16; ++i) { LAS float* s = scr + (4 * i + (lane >> 4)) * 65 + 4 * (lane & 15); s[0] = buf[i].x; s[1] = buf[i].y; s[2] = buf[i].z; s[3] = buf[i].w; }
        const int mk0 = k0, mn0 = n0;
        f32x4v g0 = (f32x4v){1.f, 1.f, 1.f, 1.f}, g1 = g0;
        if (gain) { g0 = *(const f32x4v*)(gain + mk0 + 8 * c8); g1 = *(const f32x4v*)(gain + mk0 + 8 * c8 + 4); }
        if (it + 1 < 8) { r += NWAVES; k0 = 64 * (r / ncol); n0 = 64 * (r % ncol);
#pragma unroll
            for (int i = 0; i < 16; ++i) buf[i] = __builtin_nontemporal_load((const f32x4v*)(W + (size_t)(k0 + 4 * i + (lane >> 4)) * ldw + n0 + 4 * (lane & 15))); }
        LDS_WAIT(); asm volatile("" ::: "memory");
#pragma unroll
        for (int jj = 0; jj < 8; ++jj) { const int n = (lane >> 3) + 8 * jj; const LAS float* s = scr + (8 * c8) * 65 + n;
            v4u o; o.x = pk2(s[0 * 65] * g0.x, s[1 * 65] * g0.y); o.y = pk2(s[2 * 65] * g0.z, s[3 * 65] * g0.w); o.z = pk2(s[4 * 65] * g1.x, s[5 * 65] * g1.y); o.w = pk2(s[6 * 65] * g1.z, s[7 * 65] * g1.w);
            __builtin_nontemporal_store(o, (GAS v4u*)(WT + (size_t)(mn0 + n) * K + mk0 + 8 * c8)); }
        LDS_WAIT(); asm volatile("" ::: "memory");
    }
}
__device__ __forceinline__ double rope_inv(int i) {
    return i == 0 ? 1.0 : i == 1 ? 0.19392274474868576 : i == 2 ? 0.03760603093086393 : i == 3 ? 0.007292664737217109 : i == 4 ? 0.001414213562373095 :
           i == 5 ? 0.0002742481756762073 : i == 6 ? 5.318295896944988e-05 : 1.031338537721246e-05;
}
__device__ __forceinline__ void p0_prologue(const Frame& F, const Args& a) {
    unsigned char* ws = a.ws;
    LAS float* scr = (LAS float*)(F.lds + F.wave * 16640);
    const int gw = F.vcu * NWAVES + F.wave, NGW = F.G * NWAVES;
    for (int r = gw; r < 64 * 136; r += NGW) p0_item(a.in[I_WINA], IN0, a.in[I_ANORM], (bf16*)(ws + WS_WINA), D, 64 * (r / 136), 64 * (r % 136), scr, F.lane);
    if (F.G != 256) for (int r = gw; r < DEF_N6; r += NGW) p0_item(a.in[I_WUP] + (size_t)D * DFF, DFF, a.in[I_MNORM] + D, (bf16*)(ws + WS_WUP) + (size_t)DFF * D, D, 64 * (r / 256), 64 * (r % 256), scr, F.lane);
    for (int q = F.vcu; q < CW_P0; q += F.G) conv_chunk(F, a, q);
    { GAS v4u* z = (GAS v4u*)((bf16*)(ws + WS_WING) + (size_t)IN1 * D); const int nz = (IN1P - IN1) * D / 8;
      for (int i = gw * 64 + F.lane; i < nz; i += NGW * 64) z[i] = (v4u){0u, 0u, 0u, 0u}; }
    float* ssq0 = (float*)(ws + WS_SSQ);
    for (int m = gw; m < M; m += NGW) {
        const float* xr = (m < NP) ? a.in[I_XP] + (size_t)m * D : a.in[I_XS] + (size_t)(m - NP) * D;
        bf16* ob = (bf16*)(ws + WS_XB) + (size_t)m * D;
        float s = 0.f;
#pragma unroll
        for (int j = 0; j < 8; ++j) {
            const f32x4v v0 = __builtin_nontemporal_load((const f32x4v*)(xr + j * 512 + F.lane * 8)), v1 = __builtin_nontemporal_load((const f32x4v*)(xr + j * 512 + F.lane * 8 + 4));
            s += (v0.x * v0.x + v0.y * v0.y) + (v0.z * v0.z + v0.w * v0.w) + (v1.x * v1.x + v1.y * v1.y) + (v1.z * v1.z + v1.w * v1.w);
            v4u o; o.x = pk2(v0.x, v0.y); o.y = pk2(v0.z, v0.w); o.z = pk2(v1.x, v1.y); o.w = pk2(v1.z, v1.w);
            *(GAS v4u*)(ob + j * 512 + F.lane * 8) = o;
        }
        s = wave_sum(s);
        if (F.lane == 0) ssq0[m] = s;
    }
    float* rope = (float*)(ws + WS_ROPE);
    for (int i = (F.vcu * NWAVES * 64) + F.tid; i < 2064 * 8; i += F.G * NWAVES * 64) {
        const int pi = i >> 3, fi = i & 7; const int pos = pi < 2048 ? pi : PAST + (pi - 2048);
        const float angf = (float)pos * (float)rope_inv(fi);
        double rev = (double)angf * 0.15915494309189535; rev -= __builtin_rint(rev);
        const float r = (float)rev;
        rope[pi * 16 + fi] = __builtin_amdgcn_cosf(r); rope[pi * 16 + 8 + fi] = __builtin_amdgcn_sinf(r);
    }
}

__device__ __forceinline__ int pperm(int x) { return (x & ~31) | ((x & 12) << 1) | ((x & 16) >> 2) | (x & 3); }
__device__ __forceinline__ int cswz(int pcol, int m) { return (((pcol >> 3) ^ m) << 3) | (pcol & 7); }
typedef unsigned u32x2v __attribute__((ext_vector_type(2)));
__device__ __forceinline__ bf16x8 mk8(float a0, float a1, float a2, float a3, float a4, float a5, float a6, float a7) {
    v4u t; t.x = pg8::cvt_pk_bf16(a0, a1); t.y = pg8::cvt_pk_bf16(a2, a3); t.z = pg8::cvt_pk_bf16(a4, a5); t.w = pg8::cvt_pk_bf16(a6, a7); return __builtin_bit_cast(bf16x8, t); }
#define OPQ(v_) ({ int _t = (v_); asm volatile("" : "+v"(_t)); _t; })
__device__ __forceinline__ void p0_deferred(const Frame& F, const Args& a, int which, int j) {
    LAS float* scr = (LAS float*)(F.lds + F.wave * 16640);
    const int lane = F.lane, c8 = lane & 7;
    const float* W; const float* gain; bf16* WT; int ldw, K, ncol;
    if (which == 1) { W = a.in[I_WDN] + (size_t)DFF * D; gain = nullptr; WT = (bf16*)(a.ws + WS_WDN) + (size_t)D * DFF; ldw = D; K = DFF; ncol = 64; }
    else            { W = a.in[I_WUP] + (size_t)D * DFF; gain = a.in[I_MNORM] + D; WT = (bf16*)(a.ws + WS_WUP) + (size_t)DFF * D; ldw = DFF; K = D; ncol = 256; }
    f32x4v buf[16];
    const int DEF_Q = (which == 1) ? DEF_Q1 : DEF_Q6;
    int r = j * DEF_Q + F.wave; int k0 = 64 * (r / ncol), n0 = 64 * (r % ncol);
#pragma unroll
    for (int i = 0; i < 16; ++i) buf[i] = __builtin_nontemporal_load((const f32x4v*)(W + (size_t)(k0 + 4 * i + (lane >> 4)) * ldw + n0 + 4 * (lane & 15)));
    for (int q = F.wave; q < DEF_Q; q += NWAVES) {
#pragma unroll
        for (int i = 0; i < 16; ++i) { LAS float* s = scr + (4 * i + (lane >> 4)) * 65 + 4 * (lane & 15); s[0] = buf[i].x; s[1] = buf[i].y; s[2] = buf[i].z; s[3] = buf[i].w; }
        const int mk0 = k0, mn0 = n0;
        f32x4v g0 = (f32x4v){1.f, 1.f, 1.f, 1.f}, g1 = g0;
        if (gain) { g0 = *(const f32x4v*)(gain + mk0 + 8 * c8); g1 = *(const f32x4v*)(gain + mk0 + 8 * c8 + 4); }
        if (q + NWAVES < DEF_Q) { r += NWAVES; k0 = 64 * (r / ncol); n0 = 64 * (r % ncol);
#pragma unroll
            for (int i = 0; i < 16; ++i) buf[i] = __builtin_nontemporal_load((const f32x4v*)(W + (size_t)(k0 + 4 * i + (lane >> 4)) * ldw + n0 + 4 * (lane & 15))); }
        LDS_WAIT(); asm volatile("" ::: "memory");
#pragma unroll
        for (int jj = 0; jj < 8; ++jj) { const int n = (lane >> 3) + 8 * jj; const LAS float* s = scr + (8 * c8) * 65 + n;
            v4u o; o.x = pk2(s[0 * 65] * g0.x, s[1 * 65] * g0.y); o.y = pk2(s[2 * 65] * g0.z, s[3 * 65] * g0.w); o.z = pk2(s[4 * 65] * g1.x, s[5 * 65] * g1.y); o.w = pk2(s[6 * 65] * g1.z, s[7 * 65] * g1.w);
            __builtin_nontemporal_store(o, (GAS v4u*)(WT + (size_t)(mn0 + n) * K + mk0 + 8 * c8)); }
        LDS_WAIT(); asm volatile("" ::: "memory");
    }
}
__device__ __forceinline__ void rope8(float* mine, const float* other, const float* cs, bool second) {
#pragma unroll
    for (int i = 0; i < 8; ++i) mine[i] = second ? (mine[i] * cs[i] + other[i] * cs[8 + i]) : (mine[i] * cs[i] - other[i] * cs[8 + i]);
}
__device__ __forceinline__ void attn_phase(const Frame& F, const Args& a) {
    unsigned char* ws = a.ws;
    const bf16* proj = (const bf16*)(ws + WS_BIG); bf16* mix = (bf16*)(ws + WS_MIX);
    const float* rope = (const float*)(ws + WS_ROPE);
    constexpr int AK_STR = 72, AV_STR = 200;
    LAS bf16* kN = (LAS bf16*)F.lds; LAS bf16* vT = kN + 192 * AK_STR;
    const int tid = F.tid, lane = F.lane, w = F.wave;
    constexpr int NU = 1024 + 64;
#define AMFMA(A_, B_, C_) __builtin_amdgcn_mfma_f32_16x16x32_bf16((A_), (B_), (C_), 0, 0, 0)
    for (int u = F.vcu; u < NU; u += F.G) {
        const bool samp = u >= 1024;
        int n, c, kvh, kb0, nvalid;
        if (!samp) { n = u >> 7; c = (u >> 2) & 31; kvh = u & 3; kb0 = c >= 2 ? 0 : (2 - c); nvalid = 192; }
        else { const int v = u - 1024; n = v >> 2; c = 0; kvh = v & 3; kb0 = 0; nvalid = 144; }
        const int head = kvh * 8 + w;
        v4u kraw[3], vraw[3], qraw[2][2][2];
        { const int td = OPQ(tid);
#pragma unroll
          for (int it = 0; it < 3; ++it) { const int slot = it * 512 + td, j = slot >> 3, ch = slot & 7, pos = (c - 2) * 64 + j;
              kraw[it] = (v4u){0u, 0u, 0u, 0u}; vraw[it] = kraw[it];
              if (!samp && pos >= 0) { const bf16* r = proj + ((size_t)n * SEQ + pos) * IN0 + kvh * 64 + ch * 8; kraw[it] = *(const GAS v4u*)(r + C_K); vraw[it] = *(const GAS v4u*)(r + C_V); } }
          const int ln = OPQ(lane), r16 = ln & 15, g4 = ln >> 4;
#pragma unroll
          for (int qh = 0; qh < 2; ++qh)
#pragma unroll
              for (int qt = 0; qt < 2; ++qt) { const int ql = qh * 32 + qt * 16 + r16;
                  const size_t qr = samp ? (size_t)NP + n * NST + r16 : (size_t)n * SEQ + c * 64 + ql;
                  const bf16* qp = proj + qr * IN0 + head * 64 + 8 * g4; qraw[qh][qt][0] = *(const GAS v4u*)qp; qraw[qh][qt][1] = *(const GAS v4u*)(qp + 32); } }
        __syncthreads();
#pragma unroll
        for (int it = 0; it < 3; ++it) {
            const int slot = it * 512 + OPQ(tid), j = slot >> 3, ch = slot & 7;
            float kf[8], vf[8]; bool rot = false; int pi = 0;
#pragma unroll
            for (int i = 0; i < 8; ++i) { kf[i] = 0.f; vf[i] = 0.f; }
            if (!samp) {
                const int pos = (c - 2) * 64 + j;
                if (pos >= 0) { unpack8(kraw[it], kf); unpack8(vraw[it], vf); rot = true; pi = pos; }
            } else {
                if (j < 128) { const size_t o = (((size_t)n * 128 + j) * 4 + kvh) * 64 + ch * 8;
                    const f32x4v k0 = *(const f32x4v*)(a.in[I_CK] + o), k1 = *(const f32x4v*)(a.in[I_CK] + o + 4), v0 = *(const f32x4v*)(a.in[I_CV] + o), v1 = *(const f32x4v*)(a.in[I_CV] + o + 4);
                    kf[0] = k0.x; kf[1] = k0.y; kf[2] = k0.z; kf[3] = k0.w; kf[4] = k1.x; kf[5] = k1.y; kf[6] = k1.z; kf[7] = k1.w;
                    vf[0] = v0.x; vf[1] = v0.y; vf[2] = v0.z; vf[3] = v0.w; vf[4] = v1.x; vf[5] = v1.y; vf[6] = v1.z; vf[7] = v1.w; }
                else if (j < 144) { const bf16* r = proj + ((size_t)NP + n * NST + (j - 128)) * IN0 + kvh * 64 + ch * 8;
                    unpack8(*(const GAS v4u*)(r + C_K), kf); unpack8(*(const GAS v4u*)(r + C_V), vf); rot = true; pi = 2048 + (j - 128); }
            }
            float ot[8];
#pragma unroll
            for (int i = 0; i < 8; ++i) ot[i] = __shfl_xor(kf[i], 1);
            if (rot && ch < 2) { float cs[16];
#pragma unroll
                for (int i = 0; i < 4; ++i) { const f32x4v t = *(const f32x4v*)(rope + pi * 16 + 4 * i); cs[4 * i] = t.x; cs[4 * i + 1] = t.y; cs[4 * i + 2] = t.z; cs[4 * i + 3] = t.w; }
                rope8(kf, ot, cs, ch == 1); }
            { v4u kw; kw.x = pg8::cvt_pk_bf16(kf[0], kf[1]); kw.y = pg8::cvt_pk_bf16(kf[2], kf[3]); kw.z = pg8::cvt_pk_bf16(kf[4], kf[5]); kw.w = pg8::cvt_pk_bf16(kf[6], kf[7]);
              *(LAS v4u*)(kN + j * AK_STR + ch * 8) = kw;
              LAS bf16* vd = vT + (ch * 8) * AV_STR + cswz(pperm(j), ch >> 1);
#pragma unroll
              for (int i = 0; i < 8; ++i) vd[i * AV_STR] = (bf16)(pg8::cvt_pk_bf16(vf[i], 0.f) & 0xffffu); }
            int p = -1; float* ko = nullptr; float* vo = nullptr;
            if (!samp) { if (c == 31 && j >= 64) { p = j - 64; ko = a.out + O_KP; vo = a.out + O_VP; } }
            else { if (j >= 16 && j < 144) { p = j - 16; ko = a.out + O_KS; vo = a.out + O_VS; } }
            if (p >= 0) { const size_t o = (((size_t)n * 128 + p) * 4 + kvh) * 64 + ch * 8;
                *(f32x4v*)(ko + o) = (f32x4v){kf[0], kf[1], kf[2], kf[3]}; *(f32x4v*)(ko + o + 4) = (f32x4v){kf[4], kf[5], kf[6], kf[7]};
                *(f32x4v*)(vo + o) = (f32x4v){vf[0], vf[1], vf[2], vf[3]}; *(f32x4v*)(vo + o + 4) = (f32x4v){vf[4], vf[5], vf[6], vf[7]}; }
        }
        __syncthreads();
        const float sinkv = a.in[I_SINKS][head];
#pragma unroll
        for (int qh = 0; qh < 2; ++qh) { if (samp && qh == 1) break;
            const int ln = OPQ(lane), r16 = ln & 15, g4 = ln >> 4;
            bf16x8 qf[2][2];
#pragma unroll
            for (int qt = 0; qt < 2; ++qt) {
                const int ql = qh * 32 + qt * 16 + r16;
                const int qpi = samp ? 2048 + r16 : c * 64 + ql;
                const v4u w0 = qraw[qh][qt][0], w1 = qraw[qh][qt][1];
                float x[8], y[8], ot[8]; unpack8(w0, x); unpack8(w1, y);
                v4u wo; wo.x = __shfl_xor(w0.x, 16); wo.y = __shfl_xor(w0.y, 16); wo.z = __shfl_xor(w0.z, 16); wo.w = __shfl_xor(w0.w, 16); unpack8(wo, ot);
                if (g4 < 2) { float cs[16];
#pragma unroll
                    for (int i = 0; i < 4; ++i) { const f32x4v t = *(const f32x4v*)(rope + qpi * 16 + 4 * i); cs[4 * i] = t.x; cs[4 * i + 1] = t.y; cs[4 * i + 2] = t.z; cs[4 * i + 3] = t.w; }
                    rope8(x, ot, cs, g4 == 1); }
                qf[qt][0] = mk8(x[0] * 0.125f, x[1] * 0.125f, x[2] * 0.125f, x[3] * 0.125f, x[4] * 0.125f, x[5] * 0.125f, x[6] * 0.125f, x[7] * 0.125f);
                qf[qt][1] = mk8(y[0] * 0.125f, y[1] * 0.125f, y[2] * 0.125f, y[3] * 0.125f, y[4] * 0.125f, y[5] * 0.125f, y[6] * 0.125f, y[7] * 0.125f);
            }
            float mx[2] = {sinkv, sinkv}, ls[2]; ls[0] = (g4 == 0) ? 1.0f : 0.0f; ls[1] = ls[0];
            f32x4 O[4][2];
#pragma unroll
            for (int dt = 0; dt < 4; ++dt)
#pragma unroll
                for (int qt = 0; qt < 2; ++qt) O[dt][qt] = (f32x4){0.f, 0.f, 0.f, 0.f};
#pragma unroll 1
            for (int kb = kb0; kb < 3; ++kb) {
                f32x4 S[4][2];
#pragma unroll
                for (int kt = 0; kt < 4; ++kt)
#pragma unroll
                    for (int qt = 0; qt < 2; ++qt) S[kt][qt] = (f32x4){0.f, 0.f, 0.f, 0.f};
                { bf16x8 ak[2][4];
#pragma unroll
                  for (int ks = 0; ks < 2; ++ks)
#pragma unroll
                      for (int kt = 0; kt < 4; ++kt) ak[ks][kt] = *(const LAS bf16x8*)(kN + (64 * kb + 16 * kt + r16) * AK_STR + 32 * ks + 8 * g4);
#pragma unroll
                  for (int ks = 0; ks < 2; ++ks)
#pragma unroll
                      for (int kt = 0; kt < 4; ++kt)
#pragma unroll
                          for (int qt = 0; qt < 2; ++qt) S[kt][qt] = AMFMA(ak[ks][kt], qf[qt][ks], S[kt][qt]); }
                bf16x8 av[2][4];
#pragma unroll
                for (int ksk = 0; ksk < 2; ++ksk)
#pragma unroll
                    for (int dt = 0; dt < 4; ++dt) av[ksk][dt] = *(const LAS bf16x8*)(vT + (16 * dt + r16) * AV_STR + (((8 * kb + 4 * ksk + g4) ^ dt) << 3));
                if (64 * kb + 64 > nvalid) {
#pragma unroll
                    for (int kt = 0; kt < 4; ++kt)
#pragma unroll
                        for (int rr = 0; rr < 4; ++rr) if (64 * kb + 16 * kt + 4 * g4 + rr >= nvalid) { S[kt][0][rr] = -1e30f; S[kt][1][rr] = -1e30f; } }
                bf16x8 pb[2][2];
#pragma unroll
                for (int qt = 0; qt < 2; ++qt) {
                    float bm = -1e30f;
#pragma unroll
                    for (int kt = 0; kt < 4; ++kt) bm = fmaxf(fmaxf(bm, fmaxf(S[kt][qt][0], S[kt][qt][1])), fmaxf(S[kt][qt][2], S[kt][qt][3]));
                    bm = fmaxf(bm, __shfl_xor(bm, 16)); bm = fmaxf(bm, __shfl_xor(bm, 32));
                    const float mn = fmaxf(mx[qt], bm), corr = __expf(mx[qt] - mn); mx[qt] = mn;
                    float lsum = 0.f;
#pragma unroll
                    for (int kt = 0; kt < 4; ++kt)
#pragma unroll
                        for (int rr = 0; rr < 4; ++rr) { const float p = __expf(S[kt][qt][rr] - mn); S[kt][qt][rr] = p; lsum += p; }
                    ls[qt] = ls[qt] * corr + lsum;
#pragma unroll
                    for (int dt = 0; dt < 4; ++dt) O[dt][qt] = O[dt][qt] * corr;
                    pb[qt][0] = mk8(S[0][qt][0], S[0][qt][1], S[0][qt][2], S[0][qt][3], S[1][qt][0], S[1][qt][1], S[1][qt][2], S[1][qt][3]);
                    pb[qt][1] = mk8(S[2][qt][0], S[2][qt][1], S[2][qt][2], S[2][qt][3], S[3][qt][0], S[3][qt][1], S[3][qt][2], S[3][qt][3]);
                }
#pragma unroll
                for (int ksk = 0; ksk < 2; ++ksk)
#pragma unroll
                    for (int dt = 0; dt < 4; ++dt)
#pragma unroll
                        for (int qt = 0; qt < 2; ++qt) O[dt][qt] = AMFMA(av[ksk][dt], pb[qt][ksk], O[dt][qt]);
            }
#pragma unroll
            for (int qt = 0; qt < 2; ++qt) {
                float lt = ls[qt]; lt += __shfl_xor(lt, 16); lt += __shfl_xor(lt, 32);
                const float il = 1.0f / lt;
                const int ql = qh * 32 + qt * 16 + r16;
                const bool act = samp ? (qt == 0) : true;
                const size_t qr = samp ? (size_t)NP + n * NST + r16 : (size_t)n * SEQ + c * 64 + ql;
                if (act) {
#pragma unroll
                    for (int dt = 0; dt < 4; ++dt) { u32x2v o; o.x = pg8::cvt_pk_bf16(O[dt][qt][0] * il, O[dt][qt][1] * il); o.y = pg8::cvt_pk_bf16(O[dt][qt][2] * il, O[dt][qt][3] * il);
                        *(GAS u32x2v*)(mix + qr * D + head * 64 + 16 * dt + 4 * g4) = o; } }
            }
        }
    }
#undef AMFMA
    {
        const float* cw = a.in[I_SCW];
        const int cg = tid & 255, hf = tid >> 8, ch0 = cg * 8;
        float w0[8], w1[8], w2[8];
#pragma unroll
        for (int i = 0; i < 8; ++i) { w0[i] = cw[ch0 + i]; w1[i] = cw[2048 + ch0 + i]; w2[i] = cw[4096 + ch0 + i]; }
        for (int u = F.vcu; u < 512 + 16; u += F.G) {
            int T, ta, tb; size_t rowb; const float* st = nullptr; float* so;
            if (u < 512) { const int n = u >> 6, seg = u & 63; T = SEQ; rowb = (size_t)n * SEQ; ta = seg * 32 + hf * 16; tb = ta + 16; so = a.out + O_CP + (size_t)n * 2 * 2048; }
            else { const int n = u - 512; T = NST; rowb = (size_t)NP + n * NST; ta = hf * 8; tb = ta + 8; st = a.in[I_SSC] + (size_t)n * 2 * 2048; so = a.out + O_CS + (size_t)n * 2 * 2048; }
            float um2[8], um1[8];
#pragma unroll
            for (int i = 0; i < 8; ++i) { um2[i] = 0.f; um1[i] = 0.f; }
            for (int t = ta - 2; t < tb; ++t) {
                float uc[8], bg[8];
                if (t >= 0) { const bf16* r = proj + (rowb + t) * IN0 + ch0; float cgv[8], xv[8];
                    unpack8(*(const GAS v4u*)(r + C_C), cgv); unpack8(*(const GAS v4u*)(r + C_X), xv); unpack8(*(const GAS v4u*)(r + C_B), bg);
#pragma unroll
                    for (int i = 0; i < 8; ++i) uc[i] = cgv[i] * xv[i]; }
                else {
#pragma unroll
                    for (int i = 0; i < 8; ++i) { uc[i] = st ? st[(size_t)(2 + t) * 2048 + ch0 + i] : 0.f; bg[i] = 0.f; } }
                if (t >= ta) { float z[8];
#pragma unroll
                    for (int i = 0; i < 8; ++i) z[i] = bg[i] * (w0[i] * um2[i] + w1[i] * um1[i] + w2[i] * uc[i]);
                    *(GAS v4u*)(mix + (rowb + t) * D + 2048 + ch0) = pack8(z); }
                if (t >= T - 2 && t >= ta) { float* o = so + (size_t)(t - (T - 2)) * 2048 + ch0;
                    *(f32x4v*)o = (f32x4v){uc[0], uc[1], uc[2], uc[3]}; *(f32x4v*)(o + 4) = (f32x4v){uc[4], uc[5], uc[6], uc[7]}; }
#pragma unroll
                for (int i = 0; i < 8; ++i) { um2[i] = um1[i]; um1[i] = uc[i]; }
            }
        }
    }
}

constexpr int GQ_STR = 136, GT_STR = 72;
constexpr int G_QP = 0, G_KP = 17408, G_KT = 34816, G_VT = 53248, G_WP = 71680, G_AQ = 89088, G_TU = 98304, G_TW = 107520, G_AF = 116736, G_ST = 71680, G_SM = 137216;
constexpr int G_CW = 139264;
constexpr int G_OS = G_TU;
constexpr int AF_STR = 68;
#define GMFMA(A_, B_, C_) __builtin_amdgcn_mfma_f32_16x16x32_bf16((A_), (B_), (C_), 0, 0, 0)
#define LBAR() do { asm volatile("s_waitcnt lgkmcnt(0)" ::: "memory"); __builtin_amdgcn_s_barrier(); asm volatile("" ::: "memory"); } while (0)
__device__ __forceinline__ void gdn_phase(const Frame& F, const Args& a) {
    unsigned char* ws = a.ws;
    const bf16* proj = (const bf16*)(ws + WS_BIG); const float* aux = (const float*)(ws + WS_AUX); bf16* og = (bf16*)(ws + WS_MIX);
    LAS unsigned char* L = F.lds;
    LAS bf16* qP = (LAS bf16*)(L + G_QP); LAS bf16* kP = (LAS bf16*)(L + G_KP); LAS bf16* kT = (LAS bf16*)(L + G_KT); LAS bf16* vT = (LAS bf16*)(L + G_VT);
    LAS bf16* wP = (LAS bf16*)(L + G_WP); LAS bf16* aqP = (LAS bf16*)(L + G_AQ); LAS bf16* TuP = (LAS bf16*)(L + G_TU); LAS bf16* TwP = (LAS bf16*)(L + G_TW);
    LAS float* Af = (LAS float*)(L + G_AF); LAS float* os = (LAS float*)(L + G_OS); LAS float* stash = (LAS float*)(L + G_ST); LAS float* Xf = (LAS float*)(L + G_WP);
    LAS float* cwl = (LAS float*)(L + G_CW);
    LAS float* sm = (LAS float*)(L + G_SM); LAS float* ssq = sm; LAS float* Gs = sm + 128; LAS float* eGs = sm + 192; LAS float* eGls = sm + 256; LAS float* bes = sm + 320; LAS float* rqs = sm + 384; LAS float* rks = sm + 448;
    const int tid = F.tid, lane = F.lane, w = F.wave;
    const float* cw = a.in[I_DCW];
    for (int ch = F.vcu; ch < 256 + 512; ch += F.G) {
        const bool samp = ch >= 256;
        int n, h, T, TB; size_t rowb;
        if (!samp) { n = ch >> 5; h = ch & 31; T = SEQ; TB = 64; rowb = (size_t)n * SEQ; }
        else { const int v = ch - 256; n = v >> 5; h = v & 31; T = NST; TB = 16; rowb = (size_t)NP + n * NST; }
        const float Aexp = __expf(a.in[I_ALOG][h]), dtb = a.in[I_DTB][h];
        f32x4 S[8];
        { const int ln = OPQ(lane), r16 = ln & 15, g4 = ln >> 4;
        if (samp) { const float* s0 = a.in[I_SDN] + (((size_t)n * 32 + h) * 128) * 128;
#pragma unroll
            for (int dt = 0; dt < 8; ++dt)
#pragma unroll
                for (int rg_ = 0; rg_ < 4; ++rg_) S[dt][rg_] = s0[(size_t)(16 * dt + 4 * g4 + rg_) * 128 + 16 * w + r16]; }
        else {
#pragma unroll
            for (int dt = 0; dt < 8; ++dt) S[dt] = (f32x4){0.f, 0.f, 0.f, 0.f}; } }
        LBAR();
        if (tid < 384) {
#pragma unroll
            for (int i = 0; i < 4; ++i) cwl[i * 384 + tid] = cw[(size_t)i * QKV + (tid >> 7) * 4096 + h * 128 + (tid & 127)]; }
        if (tid < 128) ssq[tid] = 0.f;
        v4u P[10]; float av = 0.f, bv = 0.f;
#define GDN_PREFETCH(tn_) do { const int td_ = OPQ(tid), cg_ = td_ % 48, rg_ = td_ / 48, gch_ = (cg_ >> 4) * 4096 + h * 128 + (cg_ & 15) * 8; const int tn = (tn_); \
            if (rg_ < 10) { _Pragma("unroll") for (int r = 0; r < 10; ++r) { const int t = tn + rg_ * 7 + r - 3; \
                if (t >= 0 && t < T) P[r] = __builtin_nontemporal_load((const GAS v4u*)(proj + (rowb + t) * IN1M + gch_)); \
                else if (t < 0 && samp) { const float* sp = a.in[I_SDC] + ((size_t)n * 3 + (3 + t)) * QKV + gch_; P[r] = pack8(sp); } \
                else P[r] = (v4u){0u, 0u, 0u, 0u}; } } \
            if (w == 7) { const int ln_ = OPQ(lane); av = 0.f; bv = 0.f; if (ln_ < TB && tn + ln_ < T) { av = aux[(rowb + tn + ln_) * 64 + h]; bv = aux[(rowb + tn + ln_) * 64 + 32 + h]; } } } while (0)
        GDN_PREFETCH(0);
        for (int t0 = 0; t0 < T; t0 += 64) {
            LBAR();
            v4u gt0 = (v4u){0u, 0u, 0u, 0u}, gt1 = gt0;
            { const int td = OPQ(tid), r = td >> 3, j = td & 7;
              if (r < TB) { const bf16* gp = proj + (rowb + t0 + r) * IN1M + QKV + h * 128 + j * 16; gt0 = __builtin_nontemporal_load((const GAS v4u*)gp); gt1 = __builtin_nontemporal_load((const GAS v4u*)(gp + 8)); } }
            { const int td = OPQ(tid), cg = td % 48, rg = td / 48, part = cg >> 4, c0 = (cg & 15) * 8, gch = part * 4096 + h * 128 + c0;
            if (rg < 10) {
                float cwv[4][8];
#pragma unroll
                for (int i = 0; i < 4; ++i) { const f32x4v c0v = *(const LAS f32x4v*)(cwl + i * 384 + part * 128 + c0), c1v = *(const LAS f32x4v*)(cwl + i * 384 + part * 128 + c0 + 4);
                    cwv[i][0] = c0v.x; cwv[i][1] = c0v.y; cwv[i][2] = c0v.z; cwv[i][3] = c0v.w; cwv[i][4] = c1v.x; cwv[i][5] = c1v.y; cwv[i][6] = c1v.z; cwv[i][7] = c1v.w; }
                float w0[8], w1[8], w2[8]; unpack8(P[0], w0); unpack8(P[1], w1); unpack8(P[2], w2);
#pragma unroll
                for (int r = 3; r < 10; ++r) { const int t = t0 + rg * 7 + r - 3, lr = rg * 7 + r - 3;
                    float cur[8]; unpack8(P[r], cur);
                    if (t >= T - 3 && t < T) { float* o = a.out + (samp ? O_DCS : O_DCP) + ((size_t)n * 3 + (t - (T - 3))) * QKV + gch;
                        *(f32x4v*)o = (f32x4v){cur[0], cur[1], cur[2], cur[3]}; *(f32x4v*)(o + 4) = (f32x4v){cur[4], cur[5], cur[6], cur[7]}; }
                    float ss = 0.f; const float lf = (lr < TB) ? 1.0f : 0.0f; float yv[8];
#pragma unroll
                    for (int k = 0; k < 8; ++k) { const float x = __builtin_fmaf(cwv[3][k], cur[k], __builtin_fmaf(cwv[2][k], w2[k], __builtin_fmaf(cwv[1][k], w1[k], cwv[0][k] * w0[k])));
                        const float yy = x * __builtin_amdgcn_rcpf(1.0f + __expf(-x)) * lf; yv[k] = yy; ss = __builtin_fmaf(yy, yy, ss); }
                    float ssr = ss; ssr += __shfl_xor(ssr, 1); ssr += __shfl_xor(ssr, 2); ssr += __shfl_xor(ssr, 4); ssr += __shfl_xor(ssr, 8);
                    if (lr < 64) {
                        u32x2v lo, hi; lo.x = pg8::cvt_pk_bf16(yv[0], yv[1]); lo.y = pg8::cvt_pk_bf16(yv[2], yv[3]); hi.x = pg8::cvt_pk_bf16(yv[4], yv[5]); hi.y = pg8::cvt_pk_bf16(yv[6], yv[7]);
                        if (part < 2) { LAS bf16* d = (part == 0 ? qP : kP) + lr * GQ_STR + pperm(c0); *(LAS u32x2v*)d = lo; *(LAS u32x2v*)(d + 8) = hi;
                            if ((cg & 15) == 0) ssq[lr * 2 + part] = ssr; }
                        if (part >= 1) { LAS bf16* d = (part == 1 ? kT : vT) + c0 * GT_STR + cswz(pperm(lr), c0 >> 4);
                            d[0 * GT_STR] = (bf16)(lo.x & 0xffffu); d[1 * GT_STR] = (bf16)(lo.x >> 16); d[2 * GT_STR] = (bf16)(lo.y & 0xffffu); d[3 * GT_STR] = (bf16)(lo.y >> 16);
                            d[4 * GT_STR] = (bf16)(hi.x & 0xffffu); d[5 * GT_STR] = (bf16)(hi.x >> 16); d[6 * GT_STR] = (bf16)(hi.y & 0xffffu); d[7 * GT_STR] = (bf16)(hi.y >> 16); }
                    }
#pragma unroll
                    for (int k = 0; k < 8; ++k) { w0[k] = w1[k]; w1[k] = w2[k]; w2[k] = cur[k]; }
                    __builtin_amdgcn_sched_barrier(0);
                }
            } }
            if (w == 7) { float gv = 0.f, be = 0.f;
                if (lane < TB) { const float x = av + dtb; const float sp = fmaxf(x, 0.f) + log1pf(__expf(-fabsf(x)));
                    gv = -Aexp * sp; be = 1.0f / (1.0f + __expf(-bv)); }
                float Gc = gv;
#pragma unroll
                for (int o = 1; o < 64; o <<= 1) { const float t = __shfl_up(Gc, o); if (lane >= o) Gc += t; }
                const float G63 = __shfl(Gc, 63);
                Gs[lane] = Gc; eGs[lane] = __expf(Gc); eGls[lane] = __expf(G63 - Gc); bes[lane] = be; }
            if (t0 + 64 < T) GDN_PREFETCH(t0 + 64);
            LBAR();
            {
                const int ln = OPQ(lane), r16 = ln & 15, g4 = ln >> 4;
                const int ti = w >> 1, tj0 = 2 * (w & 1);
                if (tid < 64) { rqs[tid] = rsqrtf(ssq[2 * tid] + RMS6) * 0.08838834764831845f; rks[tid] = rsqrtf(ssq[2 * tid + 1] + RMS6); }
                f32x4 kk[2], qk[2];
#pragma unroll
                for (int c = 0; c < 2; ++c) { kk[c] = (f32x4){0.f, 0.f, 0.f, 0.f}; qk[c] = (f32x4){0.f, 0.f, 0.f, 0.f}; }
#pragma unroll
                for (int ks = 0; ks < 4; ++ks) {
                    const bf16x8 ak = *(const LAS bf16x8*)(kP + (16 * ti + r16) * GQ_STR + 32 * ks + 8 * g4), aq = *(const LAS bf16x8*)(qP + (16 * ti + r16) * GQ_STR + 32 * ks + 8 * g4);
#pragma unroll
                    for (int c = 0; c < 2; ++c) { const bf16x8 bk = *(const LAS bf16x8*)(kP + (16 * (tj0 + c) + r16) * GQ_STR + 32 * ks + 8 * g4);
                        kk[c] = GMFMA(ak, bk, kk[c]); qk[c] = GMFMA(aq, bk, qk[c]); }
                }
#pragma unroll
                for (int c = 0; c < 2; ++c) { const int tj = 16 * (tj0 + c) + r16; const float Gj = Gs[tj]; const int ptj = pperm(tj); const float rkj = rsqrtf(ssq[2 * tj + 1] + RMS6);
#pragma unroll
                    for (int rr = 0; rr < 4; ++rr) { const int tr = 16 * ti + 4 * g4 + rr; const float Gi = Gs[tr];
                        const float rqi = rsqrtf(ssq[2 * tr] + RMS6) * 0.08838834764831845f, rki = rsqrtf(ssq[2 * tr + 1] + RMS6);
                        const float dec = (tr >= tj) ? __expf(Gi - Gj) * rkj : 0.f;
                        Af[tr * AF_STR + tj] = (tr > tj) ? bes[tr] * rki * kk[c][rr] * dec : 0.f;
                        aqP[tr * GT_STR + ptj] = (bf16)(pg8::cvt_pk_bf16(rqi * qk[c][rr] * dec, 0.f) & 0xffffu); }
                }
            }
            LBAR();
            if (w < 4) {
                const int ln = OPQ(lane), c = ln & 15;
                float Ar[16], Tr[16];
#pragma unroll
                for (int i = 0; i < 16; ++i) Ar[i] = Af[(16 * w + i) * AF_STR + 16 * w + c];
                Tr[0] = (c == 0) ? 1.0f : 0.0f;
#pragma unroll
                for (int i = 1; i < 16; ++i) {
                    float acc0 = 0.f, acc1 = 0.f;
#pragma unroll
                    for (int j = 0; j < i; ++j) { const float sv = __builtin_bit_cast(float, __builtin_amdgcn_readlane(__builtin_bit_cast(int, Ar[i]), j));
                        if (j & 1) acc1 += sv * Tr[j]; else acc0 += sv * Tr[j]; }
                    Tr[i] = (c == i) ? 1.0f : -(acc0 + acc1);
                }
                if (ln < 16) {
#pragma unroll
                    for (int i = 0; i < 16; ++i) Xf[(16 * w + i) * AF_STR + 16 * w + c] = Tr[i]; }
            } else {
                const int t2 = OPQ(tid) - 256, zr = t2 >> 4, zc = t2 & 15;
                Xf[(0 + zr) * AF_STR + 16 + zc] = 0.f; Xf[(0 + zr) * AF_STR + 32 + zc] = 0.f; Xf[(0 + zr) * AF_STR + 48 + zc] = 0.f;
                Xf[(16 + zr) * AF_STR + 32 + zc] = 0.f; Xf[(16 + zr) * AF_STR + 48 + zc] = 0.f; Xf[(32 + zr) * AF_STR + 48 + zc] = 0.f;
            }
            LBAR();
#define INV_TASK(bi_, bb_, nterms_) do { const int ln = OPQ(lane), r = ln & 15, g = ln >> 4; const int bi = (bi_), bb = (bb_); \
                f32x4 Pm = (f32x4){0.f, 0.f, 0.f, 0.f}; \
                _Pragma("unroll") for (int jt = 0; jt < (nterms_); ++jt) { const int bj = bb + jt; \
                    const f32x4v a4 = *(const LAS f32x4v*)(Af + (16 * bi + r) * AF_STR + 16 * bj + 4 * g); \
                    const LAS float* bp = Xf + (16 * bj + 4 * g) * AF_STR + 16 * bb + r; \
                    const float b0 = bp[0], b1 = bp[AF_STR], b2 = bp[2 * AF_STR], b3 = bp[3 * AF_STR]; \
                    Pm = __builtin_amdgcn_mfma_f32_16x16x4f32(a4.x, b0, Pm, 0, 0, 0); Pm = __builtin_amdgcn_mfma_f32_16x16x4f32(a4.y, b1, Pm, 0, 0, 0); \
                    Pm = __builtin_amdgcn_mfma_f32_16x16x4f32(a4.z, b2, Pm, 0, 0, 0); Pm = __builtin_amdgcn_mfma_f32_16x16x4f32(a4.w, b3, Pm, 0, 0, 0); } \
                const f32x4v x4 = *(const LAS f32x4v*)(Xf + (16 * bi + r) * AF_STR + 16 * bi + 4 * g); \
                f32x4 Xm = (f32x4){0.f, 0.f, 0.f, 0.f}; \
                Xm = __builtin_amdgcn_mfma_f32_16x16x4f32(x4.x, Pm[0], Xm, 0, 0, 0); Xm = __builtin_amdgcn_mfma_f32_16x16x4f32(x4.y, Pm[1], Xm, 0, 0, 0); \
                Xm = __builtin_amdgcn_mfma_f32_16x16x4f32(x4.z, Pm[2], Xm, 0, 0, 0); Xm = __builtin_amdgcn_mfma_f32_16x16x4f32(x4.w, Pm[3], Xm, 0, 0, 0); \
                LAS float* xo = Xf + (16 * bi + 4 * g) * AF_STR + 16 * bb + r; \
                xo[0] = -Xm[0]; xo[AF_STR] = -Xm[1]; xo[2 * AF_STR] = -Xm[2]; xo[3 * AF_STR] = -Xm[3]; } while (0)
            if (w == 0) { INV_TASK(1, 0, 1); asm volatile("s_waitcnt lgkmcnt(0)" ::: "memory"); INV_TASK(2, 0, 2); asm volatile("s_waitcnt lgkmcnt(0)" ::: "memory"); INV_TASK(3, 0, 3); }
            else if (w == 1) { INV_TASK(2, 1, 1); asm volatile("s_waitcnt lgkmcnt(0)" ::: "memory"); INV_TASK(3, 1, 2); }
            else if (w == 2) { INV_TASK(3, 2, 1); }
            LBAR();
#undef INV_TASK
            { const int td = OPQ(tid), row = td >> 3, c0 = (td & 7) * 8;
              const f32x4v x0 = *(const LAS f32x4v*)(Xf + row * AF_STR + c0), x1 = *(const LAS f32x4v*)(Xf + row * AF_STR + c0 + 4);
              const f32x4v be0 = *(const LAS f32x4v*)(bes + c0), be1 = *(const LAS f32x4v*)(bes + c0 + 4), eg0 = *(const LAS f32x4v*)(eGs + c0), eg1 = *(const LAS f32x4v*)(eGs + c0 + 4);
              const f32x4v rk0 = *(const LAS f32x4v*)(rks + c0), rk1 = *(const LAS f32x4v*)(rks + c0 + 4);
              const f32x4v u0 = x0 * be0, u1 = x1 * be1, w0 = u0 * eg0 * rk0, w1 = u1 * eg1 * rk1;
              u32x2v lo, hi; const int pc = pperm(c0);
              lo.x = pg8::cvt_pk_bf16(u0.x, u0.y); lo.y = pg8::cvt_pk_bf16(u0.z, u0.w); hi.x = pg8::cvt_pk_bf16(u1.x, u1.y); hi.y = pg8::cvt_pk_bf16(u1.z, u1.w);
              *(LAS u32x2v*)(TuP + row * GT_STR + pc) = lo; *(LAS u32x2v*)(TuP + row * GT_STR + pc + 8) = hi;
              lo.x = pg8::cvt_pk_bf16(w0.x, w0.y); lo.y = pg8::cvt_pk_bf16(w0.z, w0.w); hi.x = pg8::cvt_pk_bf16(w1.x, w1.y); hi.y = pg8::cvt_pk_bf16(w1.z, w1.w);
              *(LAS u32x2v*)(TwP + row * GT_STR + pc) = lo; *(LAS u32x2v*)(TwP + row * GT_STR + pc + 8) = hi; }
            LBAR();
            f32x4 ub[4];
            {
                const int ln = OPQ(lane), r16 = ln & 15, g4 = ln >> 4;
                f32x4 wt[4];
#pragma unroll
                for (int tt = 0; tt < 4; ++tt) { ub[tt] = (f32x4){0.f, 0.f, 0.f, 0.f}; wt[tt] = (f32x4){0.f, 0.f, 0.f, 0.f}; }
#pragma unroll
                for (int ks = 0; ks < 2; ++ks) {
                    const bf16x8 bv = *(const LAS bf16x8*)(vT + (16 * w + r16) * GT_STR + (((4 * ks + g4) ^ w) << 3)), ak = *(const LAS bf16x8*)(kT + (16 * w + r16) * GT_STR + (((4 * ks + g4) ^ w) << 3));
#pragma unroll
                    for (int tt = 0; tt < 4; ++tt) { const bf16x8 at = *(const LAS bf16x8*)(TuP + (16 * tt + r16) * GT_STR + 32 * ks + 8 * g4), bt = *(const LAS bf16x8*)(TwP + (16 * tt + r16) * GT_STR + 32 * ks + 8 * g4);
                        ub[tt] = GMFMA(at, bv, ub[tt]); wt[tt] = GMFMA(ak, bt, wt[tt]); }
                }
                const int pd = pperm(16 * w + 4 * g4);
#pragma unroll
                for (int tt = 0; tt < 4; ++tt) { u32x2v o; o.x = pg8::cvt_pk_bf16(-wt[tt][0], -wt[tt][1]); o.y = pg8::cvt_pk_bf16(-wt[tt][2], -wt[tt][3]); *(LAS u32x2v*)(wP + (16 * tt + r16) * GQ_STR + pd) = o; }
            }
            LBAR();
            {
                const int ln = OPQ(lane), r16 = ln & 15, g4 = ln >> 4;
                bf16x8 Sb[4];
#pragma unroll
                for (int ks = 0; ks < 4; ++ks) Sb[ks] = mk8(S[2 * ks][0], S[2 * ks][1], S[2 * ks][2], S[2 * ks][3], S[2 * ks + 1][0], S[2 * ks + 1][1], S[2 * ks + 1][2], S[2 * ks + 1][3]);
                f32x4 u[4], o[4];
#pragma unroll
                for (int tt = 0; tt < 4; ++tt) { u[tt] = ub[tt]; o[tt] = (f32x4){0.f, 0.f, 0.f, 0.f}; }
#pragma unroll
                for (int ks = 0; ks < 4; ++ks)
#pragma unroll
                    for (int tt = 0; tt < 4; ++tt) { const bf16x8 aw = *(const LAS bf16x8*)(wP + (16 * tt + r16) * GQ_STR + 32 * ks + 8 * g4), aq = *(const LAS bf16x8*)(qP + (16 * tt + r16) * GQ_STR + 32 * ks + 8 * g4);
                        u[tt] = GMFMA(aw, Sb[ks], u[tt]); o[tt] = GMFMA(aq, Sb[ks], o[tt]); }
#pragma unroll
                for (int tt = 0; tt < 4; ++tt)
#pragma unroll
                    for (int rr = 0; rr < 4; ++rr) o[tt][rr] *= eGs[16 * tt + 4 * g4 + rr] * rqs[16 * tt + 4 * g4 + rr];
                bf16x8 Ub[2], Us[2];
#pragma unroll
                for (int ks = 0; ks < 2; ++ks) {
                    Ub[ks] = mk8(u[2 * ks][0], u[2 * ks][1], u[2 * ks][2], u[2 * ks][3], u[2 * ks + 1][0], u[2 * ks + 1][1], u[2 * ks + 1][2], u[2 * ks + 1][3]);
                    float e[8];
#pragma unroll
                    for (int rr = 0; rr < 4; ++rr) { e[rr] = u[2 * ks][rr] * (eGls[32 * ks + 4 * g4 + rr] * rks[32 * ks + 4 * g4 + rr]); e[4 + rr] = u[2 * ks + 1][rr] * (eGls[32 * ks + 16 + 4 * g4 + rr] * rks[32 * ks + 16 + 4 * g4 + rr]); }
                    Us[ks] = mk8(e[0], e[1], e[2], e[3], e[4], e[5], e[6], e[7]);
                }
#pragma unroll
                for (int ks = 0; ks < 2; ++ks)
#pragma unroll
                    for (int tt = 0; tt < 4; ++tt) { const bf16x8 aa = *(const LAS bf16x8*)(aqP + (16 * tt + r16) * GT_STR + 32 * ks + 8 * g4); o[tt] = GMFMA(aa, Ub[ks], o[tt]); }
                const float cd = eGs[63];
#pragma unroll
                for (int dt = 0; dt < 8; ++dt) { S[dt] = S[dt] * cd;
#pragma unroll
                    for (int ks = 0; ks < 2; ++ks) { const bf16x8 ak = *(const LAS bf16x8*)(kT + (16 * dt + r16) * GT_STR + (((4 * ks + g4) ^ dt) << 3)); S[dt] = GMFMA(ak, Us[ks], S[dt]); } }
#pragma unroll
                for (int tt = 0; tt < 4; ++tt)
#pragma unroll
                    for (int rr = 0; rr < 4; ++rr) os[(16 * tt + 4 * g4 + rr) * 128 + 16 * w + r16] = o[tt][rr];
            }
            LBAR();
            { const int td = OPQ(tid), r = td >> 3, j = td & 7;
              if (r < TB) { float ov[16]; float ss = 0.f;
#pragma unroll
                for (int i = 0; i < 4; ++i) { const f32x4v t4 = *(const LAS f32x4v*)(os + r * 128 + j * 16 + 4 * i); ov[4 * i] = t4.x; ov[4 * i + 1] = t4.y; ov[4 * i + 2] = t4.z; ov[4 * i + 3] = t4.w; ss += (t4.x * t4.x + t4.y * t4.y) + (t4.z * t4.z + t4.w * t4.w); }
                ss += __shfl_xor(ss, 1); ss += __shfl_xor(ss, 2); ss += __shfl_xor(ss, 4);
                const float rs = rsqrtf(ss * (1.0f / 128.0f) + RMS6);
                const size_t row = rowb + t0 + r; float gt[16];
                unpack8(gt0, gt); unpack8(gt1, gt + 8);
                const float* onw = a.in[I_ONW] + j * 16;
#pragma unroll
                for (int i = 0; i < 16; ++i) ov[i] = ov[i] * rs * onw[i] * siluf(gt[i]);
                *(GAS v4u*)(og + row * D + h * 128 + j * 16) = pack8(ov); *(GAS v4u*)(og + row * D + h * 128 + j * 16 + 8) = pack8(ov + 8); }
            }
        }
        { const int ln = OPQ(lane), r16 = ln & 15, g4 = ln >> 4; float* so = a.out + (samp ? O_DSS : O_DSP) + (((size_t)n * 32 + h) * 128) * 128;
#pragma unroll
          for (int dt = 0; dt < 8; ++dt)
#pragma unroll
              for (int rr = 0; rr < 4; ++rr) so[(size_t)(16 * dt + 4 * g4 + rr) * 128 + 16 * w + r16] = S[dt][rr]; }
    }
}
#undef GMFMA
#undef LBAR
#undef GDN_PREFETCH

__device__ __forceinline__ void final_phase(const Frame& F, const Args& a) {
    const float* ssq = (const float*)(a.ws + WS_SSQ) + 4 * (size_t)M; const float* g = a.in[I_FNORM];
    const int gw = F.vcu * NWAVES + F.wave, NGW = F.G * NWAVES;
    for (int m = gw; m < M; m += NGW) {
        float* yr = a.out + O_Y + (size_t)m * D; const float rs = rsqrtf(ssq[m] * (1.0f / D) + RMS6);
#pragma unroll
        for (int j = 0; j < 16; ++j) { const int c = j * 256 + F.lane * 4; f32x4v v = *(const f32x4v*)(yr + c); const f32x4v gg = *(const f32x4v*)(g + c);
            v.x = v.x * rs * gg.x; v.y = v.y * rs * gg.y; v.z = v.z * rs * gg.z; v.w = v.w * rs * gg.w; __builtin_nontemporal_store(v, (f32x4v*)(yr + c)); }
    }
}

__device__ __forceinline__ void ssq_reduce(const Frame& F, const float* part, float* ssq) {
    for (int b = F.vcu; b < NP / 64; b += F.G) { const int row = 64 * b + (F.tid >> 3), j = F.tid & 7;
        const f32x4v p0 = *(const f32x4v*)(part + (size_t)row * 64 + 8 * j), p1 = *(const f32x4v*)(part + (size_t)row * 64 + 8 * j + 4);
        float s = ((p0.x + p0.y) + (p0.z + p0.w)) + ((p1.x + p1.y) + (p1.z + p1.w));
        s += __shfl_xor(s, 1); s += __shfl_xor(s, 2); s += __shfl_xor(s, 4);
        if (j == 0) ssq[row] = s; }
}
__device__ __forceinline__ void sample_finalize(const Frame& F, const float* slab, int nsplit, const float* base_f, const bf16* base_b, float* out_f, bf16* out_b, float* ssq) {
    LAS float* red = (LAS float*)(F.lds + SMALL_OFF);
    for (int r = F.vcu; r < 256; r += F.G) {
        const int c0 = F.tid * 8, pn = c0 >> 8, cc = c0 & 255;
        f32x4v a0, a1;
        if (base_f) { a0 = *(const f32x4v*)(base_f + (size_t)r * D + c0); a1 = *(const f32x4v*)(base_f + (size_t)r * D + c0 + 4); }
        else { float t[8]; unpack8(*(const GAS v4u*)(base_b + (size_t)r * D + c0), t); a0 = (f32x4v){t[0], t[1], t[2], t[3]}; a1 = (f32x4v){t[4], t[5], t[6], t[7]}; }
        for (int ks = 0; ks < nsplit; ++ks) { const float* sp = slab + ((size_t)(pn * nsplit + ks) * 256 + r) * 256 + cc; a0 = a0 + *(const f32x4v*)sp; a1 = a1 + *(const f32x4v*)(sp + 4); }
        if (out_f) { *(f32x4v*)(out_f + (size_t)r * D + c0) = a0; *(f32x4v*)(out_f + (size_t)r * D + c0 + 4) = a1; }
        if (out_b) { v4u o; o.x = pk2(a0.x, a0.y); o.y = pk2(a0.z, a0.w); o.z = pk2(a1.x, a1.y); o.w = pk2(a1.z, a1.w); *(GAS v4u*)(out_b + (size_t)r * D + c0) = o; }
        float s = (a0.x * a0.x + a0.y * a0.y) + (a0.z * a0.z + a0.w * a0.w) + (a1.x * a1.x + a1.y * a1.y) + (a1.z * a1.z + a1.w * a1.w);
        s = wave_sum(s);
        __syncthreads();
        if (F.lane == 0) red[F.wave] = s;
        __syncthreads();
        if (F.tid == 0) { float t = 0.f;
#pragma unroll
            for (int i = 0; i < NWAVES; ++i) t += red[i];
            ssq[r] = t; }
    }
}
__device__ __forceinline__ void sample_finalize_up(const Frame& F, const float* slab, const float* ssq, bf16* hid) {
    for (int r = F.vcu; r < 256; r += F.G) {
        const float rs = rsqrtf(ssq[r] * (1.0f / D) + RMS6);
#pragma unroll
        for (int it = 0; it < 4; ++it) { const int c0 = (it * 512 + F.tid) * 8, pn = c0 >> 8, cc = c0 & 255;
            f32x4v a0 = (f32x4v){0.f, 0.f, 0.f, 0.f}, a1 = a0;
#pragma unroll
            for (int ks = 0; ks < 4; ++ks) { const float* sp = slab + ((size_t)(pn * 4 + ks) * 256 + r) * 256 + cc; a0 = a0 + *(const f32x4v*)sp; a1 = a1 + *(const f32x4v*)(sp + 4); }
            float z[8] = {a0.x, a0.y, a0.z, a0.w, a1.x, a1.y, a1.z, a1.w};
#pragma unroll
            for (int i = 0; i < 8; ++i) { const float t = fmaxf(z[i] * rs, 0.f); z[i] = t * t; }
            *(GAS v4u*)(hid + (size_t)r * DFF + c0) = pack8(z); }
    }
}

__device__ __forceinline__ int claim_unit(const Frame& F, unsigned* ctr) {
    volatile LAS unsigned* MISC = (volatile LAS unsigned*)(F.lds + MISC_OFF);
    if (F.tid == 0) MISC[24] = __hip_atomic_fetch_add(ctr, 1u, __ATOMIC_RELAXED, __HIP_MEMORY_SCOPE_AGENT);
    __syncthreads(); const unsigned j = MISC[24]; __syncthreads();
    return __builtin_amdgcn_readfirstlane((int)j);
}
__global__ void __launch_bounds__(NWAVES * 64, 2) mk_fwd(Args args) {
    extern __shared__ __attribute__((aligned(16))) unsigned char lds[];
    Frame F;
    F.lds = (LAS unsigned char*)lds;
    volatile LAS unsigned* MISC = (volatile LAS unsigned*)(F.lds + MISC_OFF);
    F.tid = threadIdx.x; F.lane = F.tid & 63; F.wave = __builtin_amdgcn_readfirstlane(F.tid >> 6);
    F.G = gridDim.x; { const int bx = blockIdx.x; F.vcu = (F.G % 8 == 0) ? (bx % 8) * (F.G / 8) + bx / 8 : bx; }
    unsigned char* ws = args.ws;
    if (F.tid < 64) MISC[F.tid] = 0u;
    __syncthreads();
    XcdBarrier bar; bar.bar = (unsigned*)(ws + WS_CTL) + CW_BAR; bar.x = 0; bar.st = nullptr;
    if (MK_N_LAUNCHES == 1) bar = xcd_barrier_post((unsigned*)(ws + WS_CTL) + CW_BAR, MISC + 8);
    const int lo = args.ph_lo, hi = args.ph_hi;
#define IN(k) (lo <= (k) && (k) < hi)
#define SEAM(k) do { if (IN(k) && IN((k) + 1)) xcd_barrier(bar); } while (0)
#define xcd_barrier_always(b, lo_, hi_, k_) xcd_barrier(b)
    float* ssqb = (float*)(ws + WS_SSQ); float* slab = (float*)(ws + WS_SLAB); float* ssqp = (float*)(ws + WS_SSQP);
    bf16* xb = (bf16*)(ws + WS_XB); bf16* mixb = (bf16*)(ws + WS_MIX); bf16* big = (bf16*)(ws + WS_BIG);

    if (IN(0)) { p0_prologue(F, args); } SEAM(0);
    if (IN(1)) {
        const bool split_roles = (F.G == 256);
        if (!split_roles || (int)blockIdx.x < 224) {
            pg8::Gemm g{xb, (const bf16*)(ws + WS_WINA), M, IN0, D, D}; pg8::StaticOrder S; S.init(M, IN0, split_roles ? 224 : F.G, (int)blockIdx.x);
            pg8::EpiRow<0> E{big, IN0, ssqb, nullptr, -1};
            pg8::gemm_phase<pg8::EpiRow<0>, pg8::StaticOrder, true, true>(F.lds, g, S, E);
        }
        for (;;) { const int q = claim_unit(F, (unsigned*)(ws + WS_CTL) + CW_CLAIM + 7) + CW_P0; if (q >= CW_END) break; conv_chunk(F, args, q); }
    } SEAM(1);
    if (IN(2)) { attn_phase(F, args); } SEAM(2);
    if (IN(3)) {
        { pg8::Gemm g{mixb, (const bf16*)(ws + WS_WOUTA), NP, D, 4096, 4096}; pg8::StaticOrder S; S.init(NP, D, F.G, (int)blockIdx.x);
          pg8::EpiRes<false, false> E{xb, xb, ssqp};
          pg8::gemm_phase<pg8::EpiRes<false, false>, pg8::StaticOrder, true, true>(F.lds, g, S, E); }
        { pg8::Gemm g{mixb + (size_t)NP * 4096, (const bf16*)(ws + WS_WOUTA), 256, D, 256, 4096}; pg8::EpiSlab E{slab, 16};
          for (;;) { const int j = claim_unit(F, (unsigned*)(ws + WS_CTL) + CW_CLAIM + 0); if (j >= (D / 256) * 16) break;
              pg8::SplitOrder S{D / 256, 16, 1 << 24, j};
              pg8::gemm_phase<pg8::EpiSlab, pg8::SplitOrder, true, true>(F.lds, g, S, E); } }
        xcd_barrier_always(bar, lo, hi, 3);
        ssq_reduce(F, ssqp, ssqb + 1 * (size_t)M);
        sample_finalize(F, slab, 16, nullptr, xb + (size_t)NP * D, nullptr, xb + (size_t)NP * D, ssqb + 1 * (size_t)M + NP);
    } SEAM(3);
    if (IN(4)) {
        { pg8::Gemm g{xb, (const bf16*)(ws + WS_WUP), NP, DFF, D, D}; pg8::StaticOrder S; S.init(NP, DFF, F.G, (int)blockIdx.x);
          pg8::EpiRow<1> E{big, DFF, ssqb + 1 * (size_t)M, nullptr, -1};
          pg8::gemm_phase<pg8::EpiRow<1>, pg8::StaticOrder, true, true>(F.lds, g, S, E); }
        { pg8::Gemm g{xb + (size_t)NP * D, (const bf16*)(ws + WS_WUP), 256, DFF, 1024, D}; pg8::EpiSlab E{slab, 4};
          for (;;) { const int j = claim_unit(F, (unsigned*)(ws + WS_CTL) + CW_CLAIM + 1); if (j >= (DFF / 256) * 4) break;
              pg8::SplitOrder S{DFF / 256, 4, 1 << 24, j};
              pg8::gemm_phase<pg8::EpiSlab, pg8::SplitOrder, true, true>(F.lds, g, S, E); } }
        xcd_barrier(bar);
        sample_finalize_up(F, slab, ssqb + 1 * (size_t)M + NP, big + (size_t)NP * DFF);
    } SEAM(4);
    if (IN(5)) {
        { pg8::Gemm g{big, (const bf16*)(ws + WS_WDN), NP, D, 16384, 16384}; pg8::StaticOrder S; S.init(NP, D, F.G, (int)blockIdx.x);
          pg8::EpiRes<false, false> E{xb, xb, ssqp};
          pg8::gemm_phase<pg8::EpiRes<false, false>, pg8::StaticOrder, true, true>(F.lds, g, S, E); }
        { pg8::Gemm g{big + (size_t)NP * 16384, (const bf16*)(ws + WS_WDN), 256, D, 1024, 16384}; pg8::EpiSlab E{slab, 16};
          for (;;) { const int j = claim_unit(F, (unsigned*)(ws + WS_CTL) + CW_CLAIM + 2); if (j >= (D / 256) * 16) break;
              pg8::SplitOrder S{D / 256, 16, 1 << 24, j};
              pg8::gemm_phase<pg8::EpiSlab, pg8::SplitOrder, true, true>(F.lds, g, S, E); } }
        xcd_barrier_always(bar, lo, hi, 5);
        ssq_reduce(F, ssqp, ssqb + 2 * (size_t)M);
        sample_finalize(F, slab, 16, nullptr, xb + (size_t)NP * D, nullptr, xb + (size_t)NP * D, ssqb + 2 * (size_t)M + NP);
    } SEAM(5);
    if (IN(6)) {
        pg8::Gemm g{xb, (const bf16*)(ws + WS_WING), M, IN1P, D, D}; pg8::StaticOrder S; S.init(M, IN1P, F.G, (int)blockIdx.x);
        pg8::EpiRow<0> E{big, IN1M, ssqb + 2 * (size_t)M, (float*)(ws + WS_AUX), 64};
        pg8::gemm_phase<pg8::EpiRow<0>, pg8::StaticOrder, true, true>(F.lds, g, S, E);
        if (F.G == 256 && (int)blockIdx.x >= DEF_WG6) p0_deferred(F, args, 6, (int)blockIdx.x - DEF_WG6);
    } SEAM(6);
    if (IN(7)) { gdn_phase(F, args); } SEAM(7);
    if (IN(8)) {
        { pg8::Gemm g{mixb, (const bf16*)(ws + WS_WOUTG), NP, D, 4096, 4096}; pg8::StaticOrder S; S.init(NP, D, F.G, (int)blockIdx.x);
          pg8::EpiRes<false, false> E{xb, xb, ssqp};
          pg8::gemm_phase<pg8::EpiRes<false, false>, pg8::StaticOrder, true, true>(F.lds, g, S, E); }
        { pg8::Gemm g{mixb + (size_t)NP * 4096, (const bf16*)(ws + WS_WOUTG), 256, D, 256, 4096}; pg8::EpiSlab E{slab, 16};
          for (;;) { const int j = claim_unit(F, (unsigned*)(ws + WS_CTL) + CW_CLAIM + 3); if (j >= (D / 256) * 16) break;
              pg8::SplitOrder S{D / 256, 16, 1 << 24, j};
              pg8::gemm_phase<pg8::EpiSlab, pg8::SplitOrder, true, true>(F.lds, g, S, E); } }
        xcd_barrier_always(bar, lo, hi, 8);
        ssq_reduce(F, ssqp, ssqb + 3 * (size_t)M);
        sample_finalize(F, slab, 16, nullptr, xb + (size_t)NP * D, nullptr, xb + (size_t)NP * D, ssqb + 3 * (size_t)M + NP);
    } SEAM(8);
    if (IN(9)) {
        { pg8::Gemm g{xb, (const bf16*)(ws + WS_WUP) + (size_t)DFF * D, NP, DFF, D, D}; pg8::StaticOrder S; S.init(NP, DFF, F.G, (int)blockIdx.x);
          pg8::EpiRow<1> E{big, DFF, ssqb + 3 * (size_t)M, nullptr, -1};
          pg8::gemm_phase<pg8::EpiRow<1>, pg8::StaticOrder, true, true>(F.lds, g, S, E); }
        { pg8::Gemm g{xb + (size_t)NP * D, (const bf16*)(ws + WS_WUP) + (size_t)DFF * D, 256, DFF, 1024, D}; pg8::EpiSlab E{slab, 4};
          for (;;) { const int j = claim_unit(F, (unsigned*)(ws + WS_CTL) + CW_CLAIM + 4); if (j >= (DFF / 256) * 4) break;
              pg8::SplitOrder S{DFF / 256, 4, 1 << 24, j};
              pg8::gemm_phase<pg8::EpiSlab, pg8::SplitOrder, true, true>(F.lds, g, S, E); } }
        xcd_barrier(bar);
        sample_finalize_up(F, slab, ssqb + 3 * (size_t)M + NP, big + (size_t)NP * DFF);
    } SEAM(9);
    if (IN(10)) {
        { pg8::Gemm g{big, (const bf16*)(ws + WS_WDN) + (size_t)D * DFF, NP, D, 16384, 16384}; pg8::StaticOrder S; S.init(NP, D, F.G, (int)blockIdx.x);
          pg8::EpiRes<false, true> E{xb, (args.out + O_Y), ssqp};
          pg8::gemm_phase<pg8::EpiRes<false, true>, pg8::StaticOrder, true, true>(F.lds, g, S, E); }
        { pg8::Gemm g{big + (size_t)NP * 16384, (const bf16*)(ws + WS_WDN) + (size_t)D * DFF, 256, D, 1024, 16384}; pg8::EpiSlab E{slab, 16};
          for (;;) { const int j = claim_unit(F, (unsigned*)(ws + WS_CTL) + CW_CLAIM + 5); if (j >= (D / 256) * 16) break;
              pg8::SplitOrder S{D / 256, 16, 1 << 24, j};
              pg8::gemm_phase<pg8::EpiSlab, pg8::SplitOrder, true, true>(F.lds, g, S, E); } }
        xcd_barrier_always(bar, lo, hi, 10);
        ssq_reduce(F, ssqp, ssqb + 4 * (size_t)M);
        sample_finalize(F, slab, 16, nullptr, xb + (size_t)NP * D, (args.out + O_Y) + (size_t)NP * D, nullptr, ssqb + 4 * (size_t)M + NP);
    } SEAM(10);
    if (IN(11)) { final_phase(F, args); }
#undef IN
#undef SEAM
}

extern "C" void kernel_launch(void* const* d_in, const int* in_sizes, int n_in, void* d_out, int out_size, void* d_ws, size_t ws_size, hipStream_t stream) {
    static int grid = 0;
    if (grid == 0) {
        if (n_in != 23 || in_sizes[0] != NP * D || (size_t)out_size != O_END || ws_size < WS_END) {
            fprintf(stderr, "kernel_launch: unexpected shapes: n_in %d in0 %d out %d (want %zu) ws %zu (want %zu); nothing launched\n", n_in, n_in > 0 ? in_sizes[0] : -1, out_size, (size_t)O_END, ws_size, (size_t)WS_END); grid = -1; return; }
        int dev = 0, cus = 0, per_cu = 0;
        if (hipGetDevice(&dev) != hipSuccess || hipDeviceGetAttribute(&cus, hipDeviceAttributeMultiprocessorCount, dev) != hipSuccess) { fprintf(stderr, "kernel_launch: device query failed\n"); grid = -1; return; }
        if (hipFuncSetAttribute((const void*)mk_fwd, hipFuncAttributeMaxDynamicSharedMemorySize, LDS_BYTES) != hipSuccess) { fprintf(stderr, "kernel_launch: hipFuncSetAttribute failed\n"); grid = -1; return; }
        if (hipOccupancyMaxActiveBlocksPerMultiprocessor(&per_cu, (const void*)mk_fwd, NWAVES * 64, LDS_BYTES) != hipSuccess || per_cu < 1)
            fprintf(stderr, "kernel_launch: note: occupancy query reports %d workgroups per CU\n", per_cu);
        (void)hipGetLastError();
        grid = cus;
    }
    if (grid < 0) return;
    if (hipMemsetAsync((char*)d_ws + WS_CTL, 0, CTL_ZERO_BYTES, stream) != hipSuccess) { fprintf(stderr, "kernel_launch: memset failed\n"); return; }
    Args a{};
    for (int i = 0; i < 23; ++i) a.in[i] = (const float*)d_in[i];
    a.out = (float*)d_out; a.ws = (unsigned char*)d_ws;
    if (MK_N_LAUNCHES == 1) { a.ph_lo = 0; a.ph_hi = N_PHASES; hipLaunchKernelGGL(mk_fwd, dim3(grid), dim3(NWAVES * 64), LDS_BYTES, stream, a); }
    else { for (int p = 0; p < N_PHASES; ++p) { a.ph_lo = p; a.ph_hi = p + 1; hipLaunchKernelGGL(mk_fwd, dim3(grid), dim3(NWAVES * 64), LDS_BYTES, stream, a); } }
    const hipError_t le = hipPeekAtLastError();
    if (le != hipSuccess) fprintf(stderr, "kernel_launch: launch failed: %s\n", hipGetErrorName(le));
}
```
